# Optimizing an MI355X kernel written in HIP

```python
import math
import jax, jax.numpy as jnp
from jax import lax
import numpy as np

D_MODEL = 1024
BATCH = 8
SEQ = 8192
DEPTH = 4

N_A_LAYERS = DEPTH // 2
N_B_LAYERS = DEPTH - N_A_LAYERS

GLA_HEADS = 4
GLA_DK = D_MODEL // 2 // GLA_HEADS
GLA_DV = D_MODEL // GLA_HEADS
GLA_GATE_RANK = 16
GLA_GATE_NORMALIZER = 16.0
GLA_CHUNK = 64
GLA_IN_WIDTH = 2 * GLA_HEADS * GLA_DK + 2 * GLA_HEADS * GLA_DV + GLA_GATE_RANK

DIL_PAIRS = ((128, 1), (512, 4), (2048, 16))
DIL_GROUPS = len(DIL_PAIRS)
DIL_HEADS = 16
DIL_HEAD_DIM = D_MODEL // DIL_HEADS
DIL_STEPS = DIL_PAIRS[0][0] // DIL_PAIRS[0][1]

FFN_HIDDEN = -(-8 * D_MODEL // (3 * 256)) * 256
DEEPNORM_ALPHA = (2.0 * DEPTH) ** 0.25
DEEPNORM_BETA = (8.0 * DEPTH) ** -0.25
LN_EPS = 1e-5
RMS_EPS = 1e-5

kernel_name = "yoco_gla_dilated_deepnorm_adaln"


def layer_norm(x, g, b):
    xf = x.astype(jnp.float32)
    mu = xf.mean(-1, keepdims=True)
    var = jnp.square(xf - mu).mean(-1, keepdims=True)
    return ((xf - mu) * lax.rsqrt(var + LN_EPS) * g + b).astype(x.dtype)


def modulate(x, shift, scale):
    return x * (1.0 + scale[:, None]) + shift[:, None]


def gla_chunked(q, k, v, gk):
    B, S, H, dk = q.shape
    dv = v.shape[-1]
    C = GLA_CHUNK
    n = S // C

    def chunk(a):
        return a.astype(jnp.float32).reshape(B, n, C, H, a.shape[-1]).transpose(0, 1, 3, 2, 4)

    q, k, v, gk = chunk(q), chunk(k), chunk(v), chunk(gk)
    b = jnp.cumsum(gk, axis=3)
    q_e = q * jnp.exp(b)
    k_e = k * jnp.exp(-b)
    causal = jnp.tril(jnp.ones((C, C), dtype=bool))
    attn = jnp.where(causal, jnp.einsum('bnhik,bnhjk->bnhij', q_e, k_e), 0.0)
    o_intra = jnp.einsum('bnhij,bnhjv->bnhiv', attn, v)
    b_last = b[:, :, :, -1]
    k_d = k * jnp.exp(b_last[:, :, :, None] - b)
    decay = jnp.exp(b_last)

    def step(state, xs):
        q_c, k_c, v_c, dec = xs
        o = jnp.einsum('bhik,bhkv->bhiv', q_c, state)
        state = dec[..., None] * state + jnp.einsum('bhjk,bhjv->bhkv', k_c, v_c)
        return state, o

    xs = tuple(a.swapaxes(0, 1) for a in (q_e, k_d, v, decay))
    s0 = jnp.zeros((B, H, dk, dv), jnp.float32)
    _, o_inter = lax.scan(step, s0, xs)
    o = o_intra + o_inter.swapaxes(0, 1)
    return o.transpose(0, 1, 3, 2, 4).reshape(B, S, H, dv)


def gla_mixer(h, w_in, w_gate_up, b_gate, norm_g, w_out):
    B, S, _ = h.shape
    H, dk, dv = GLA_HEADS, GLA_DK, GLA_DV
    proj = h @ w_in
    cuts = [H * dk, 2 * H * dk, 2 * H * dk + H * dv, 2 * H * dk + 2 * H * dv]
    q, k, v, r, glr = jnp.split(proj, cuts, axis=-1)
    gk = jax.nn.log_sigmoid((glr @ w_gate_up + b_gate).astype(jnp.float32)) / GLA_GATE_NORMALIZER
    o = gla_chunked((q * dk ** -0.5).reshape(B, S, H, dk), k.reshape(B, S, H, dk),
                    v.reshape(B, S, H, dv), gk.reshape(B, S, H, dk))
    o = o * lax.rsqrt(jnp.mean(jnp.square(o), -1, keepdims=True) + RMS_EPS) * norm_g
    o = o.reshape(B, S, H * dv).astype(h.dtype) * jax.nn.silu(r)
    return o @ w_out


def dilated_group(q, k, v, dilation):
    B, S, H, dh = q.shape
    L = DIL_STEPS
    span = dilation * L
    s_pad = -(-S // span) * span
    padw = ((0, 0), (0, s_pad - S), (0, 0), (0, 0))
    n = s_pad // dilation
    nb = n // L

    def to_strided(a):
        a = jnp.pad(a.astype(jnp.float32), padw)
        return a.reshape(B, n, dilation, H, dh).transpose(0, 2, 1, 3, 4).reshape(B, dilation, nb, L, H, dh)

    def with_prev(a):
        prev = jnp.concatenate([jnp.zeros_like(a[:, :, :1]), a[:, :, :-1]], axis=2)
        return jnp.concatenate([prev, a], axis=3)

    def from_strided(a):
        rest = a.shape[4:]
        a = a.reshape((B, dilation, n) + rest)
        a = jnp.moveaxis(a, 1, 2).reshape((B, s_pad) + rest)
        return a[:, :S]

    qs = to_strided(q)
    kk = with_prev(to_strided(k))
    vv = with_prev(to_strided(v))
    s = jnp.einsum('brnihd,brnjhd->brnhij', qs, kk) * dh ** -0.5
    i = jnp.arange(L)[:, None]
    j = jnp.arange(2 * L)[None, :]
    band = (j >= i) & (j <= i + L)
    valid = (jnp.arange(nb)[:, None, None] > 0) | (j >= L)[None]
    mask = band[None] & valid
    s = jnp.where(mask[None, None, :, None], s, -jnp.inf)
    m = s.max(-1, keepdims=True)
    p = jnp.exp(s - m)
    den = p.sum(-1)
    o = jnp.einsum('brnhij,brnjhd->brnihd', p, vv) / den.swapaxes(3, 4)[..., None]
    return from_strided(o), from_strided(m[..., 0].swapaxes(3, 4)), from_strided(den.swapaxes(3, 4))


def dilated_mixer(h, k_sh, v_sh, w_q, w_out):
    B, S, _ = h.shape
    q = (h @ w_q).reshape(B, S, DIL_GROUPS, DIL_HEADS, DIL_HEAD_DIM)
    outs, maxs, dens = [], [], []
    for g, (_, dil) in enumerate(DIL_PAIRS):
        o, m, d = dilated_group(q[:, :, g], k_sh, v_sh, dil)
        outs.append(o); maxs.append(m); dens.append(d)
    outs, maxs, dens = jnp.stack(outs), jnp.stack(maxs), jnp.stack(dens)
    w = dens * jnp.exp(maxs - maxs.max(0))
    o = (w[..., None] * outs).sum(0) / w.sum(0)[..., None]
    return o.reshape(B, S, D_MODEL).astype(h.dtype) @ w_out


def swiglu(h, w_in, w_out):
    g, u = jnp.split(h @ w_in, 2, axis=-1)
    return (jax.nn.silu(g) * u) @ w_out


def setup_inputs(seed: int = 0) -> dict:
    key = jax.random.key(seed)
    ks = jax.random.split(key, 20)
    D, f32 = D_MODEL, jnp.float32

    def nrm(k, shape, scale):
        return jax.random.normal(k, shape, f32) * scale

    H, dk, dv = GLA_HEADS, GLA_DK, GLA_DV
    v_col_scale = jnp.concatenate([jnp.ones((2 * H * dk,), f32), jnp.full((H * dv,), DEEPNORM_BETA, f32),
                                   jnp.ones((H * dv + GLA_GATE_RANK,), f32)])
    kv_col_scale = jnp.concatenate([jnp.ones((D,), f32), jnp.full((D,), DEEPNORM_BETA, f32)])
    return {
        "x": nrm(ks[0], (BATCH, SEQ, D), 1.0),
        "c": nrm(ks[1], (BATCH, D), 1.0),
        "gla_w_in": nrm(ks[2], (N_A_LAYERS, D, GLA_IN_WIDTH), D ** -0.5) * v_col_scale,
        "gla_w_gate_up": nrm(ks[3], (N_A_LAYERS, GLA_GATE_RANK, H * dk), GLA_GATE_RANK ** -0.5),
        "gla_b_gate": nrm(ks[4], (N_A_LAYERS, H * dk), 0.1),
        "gla_norm_g": 1.0 + nrm(ks[5], (N_A_LAYERS, dv), 0.02),
        "gla_w_out": nrm(ks[6], (N_A_LAYERS, H * dv, D), (H * dv) ** -0.5 * DEEPNORM_BETA),
        "dil_w_q": nrm(ks[7], (N_B_LAYERS, D, DIL_GROUPS * D), D ** -0.5),
        "dil_w_out": nrm(ks[8], (N_B_LAYERS, D, D), D ** -0.5 * DEEPNORM_BETA),
        "kv_ada_w": nrm(ks[9], (D, 2 * D), 0.1 * D ** -0.5),
        "kv_ada_b": nrm(ks[10], (2 * D,), 0.02),
        "w_kv": nrm(ks[11], (D, 2 * D), D ** -0.5) * kv_col_scale,
        "ffn_w_in": nrm(ks[12], (DEPTH, D, 2 * FFN_HIDDEN), D ** -0.5),
        "ffn_w_out": nrm(ks[13], (DEPTH, FFN_HIDDEN, D), FFN_HIDDEN ** -0.5 * DEEPNORM_BETA),
        "ada_w": nrm(ks[14], (DEPTH, D, 6 * D), 0.1 * D ** -0.5),
        "ada_b": nrm(ks[15], (DEPTH, 6 * D), 0.02),
        "ln_g": 1.0 + nrm(ks[16], (DEPTH, 2, D), 0.02),
        "ln_b": nrm(ks[17], (DEPTH, 2, D), 0.02),
    }


def reference(x, c, gla_w_in, gla_w_gate_up, gla_b_gate, gla_norm_g, gla_w_out, dil_w_q, dil_w_out,
              kv_ada_w, kv_ada_b, w_kv, ffn_w_in, ffn_w_out, ada_w, ada_b, ln_g, ln_b):
    B, S, D = x.shape
    alpha = DEEPNORM_ALPHA
    sc = jax.nn.silu(c)
    k_sh = v_sh = None
    for l in range(DEPTH):
        sh1, s1, g1, sh2, s2, g2 = jnp.split(sc @ ada_w[l] + ada_b[l], 6, axis=-1)
        h = modulate(x, sh1, s1)
        if l < N_A_LAYERS:
            y = gla_mixer(h, gla_w_in[l], gla_w_gate_up[l], gla_b_gate[l], gla_norm_g[l], gla_w_out[l])
        else:
            if l == N_A_LAYERS:
                kv_shift, kv_scale = jnp.split(sc @ kv_ada_w + kv_ada_b, 2, axis=-1)
                k_flat, v_flat = jnp.split(modulate(x, kv_shift, kv_scale) @ w_kv, 2, axis=-1)
                k_sh = k_flat.reshape(B, S, DIL_HEADS, DIL_HEAD_DIM)
                v_sh = v_flat.reshape(B, S, DIL_HEADS, DIL_HEAD_DIM)
            y = dilated_mixer(h, k_sh, v_sh, dil_w_q[l - N_A_LAYERS], dil_w_out[l - N_A_LAYERS])
        x = layer_norm(alpha * x + (1.0 + g1)[:, None] * y, ln_g[l, 0], ln_b[l, 0])
        h = modulate(x, sh2, s2)
        x = layer_norm(alpha * x + (1.0 + g2)[:, None] * swiglu(h, ffn_w_in[l], ffn_w_out[l]), ln_g[l, 1], ln_b[l, 1])
    return x
```

```cpp
#include <hip/hip_runtime.h>
#include <cstdio>
#include <cstdint>
namespace pg8 {
#define PG8_LAS __attribute__((address_space(3)))
typedef unsigned short bf16_t;
typedef short bf16x8 __attribute__((ext_vector_type(8)));
typedef float f32x4 __attribute__((ext_vector_type(4)));
typedef unsigned u32x4 __attribute__((ext_vector_type(4)));
constexpr int BM = 256, BK = 64, HALF = 128, HTB = HALF * BK * 2  , STAGE_BYTES = 8 * HTB, NXCD = 8, WGM = 8;

__host__ __device__ __forceinline__ int lds_byte(int r, int c) { const int st = (r >> 4) * 2 + (c >> 5), rr = r & 15, cc = c & 31, ob = rr * 64 + cc * 2; return st * 1024 + (ob ^ (((ob >> 9) & 1) << 5)); }
__host__ __device__ __forceinline__ void stage_rc(int b, int& R, int& C) { const int st = b / 1024, sb = b % 1024, swz = sb ^ (((sb >> 9) & 1) << 5); R = (st >> 1) * 16 + swz / 64; C = (st & 1) * 32 + (swz % 64) / 2; }
__host__ __device__ __forceinline__ int perm32(int rho) { const int n = rho >> 4, i = rho & 15; return 8 * (i >> 2) + 4 * n + (i & 3); }

struct Unit { int pm, pn; };
struct Gemm { const bf16_t* A; const bf16_t* Bt; int M, N, K; };

struct StaticOrder {
    int nM, nN, nwg, G, c;
    __host__ __device__ void init(int M, int N, int G_, int c_) { nM = M / BM; nN = N / BM; nwg = nM * nN; G = G_; c = c_; }
    __host__ __device__ bool next(int i, Unit& u) const {
        const long L = (long)i * G + c; if (L >= nwg) return false;
        int wgid = (int)L; { const int q = nwg / NXCD, r = nwg % NXCD, xcd = wgid % NXCD, off = wgid / NXCD; wgid = (xcd < r ? xcd * (q + 1) : r * (q + 1) + (xcd - r) * q) + off; }
        const int nig = WGM * nN, gid = wgid / nig, fm = gid * WGM, gsz = (nM - fm) < WGM ? (nM - fm) : WGM;
        u.pm = fm + ((wgid % nig) % gsz); u.pn = (wgid % nig) / gsz; return true;
    }
    __device__ __forceinline__ void a_ready(const Unit&) const {}
    __device__ __forceinline__ void done(const Unit&) const {}
};

__device__ __forceinline__ unsigned cvt_pk_bf16(float lo, float hi) { unsigned r; asm volatile("v_cvt_pk_bf16_f32 %0, %1, %2" : "=v"(r) : "v"(lo), "v"(hi)); return r; }
typedef float f32x2 __attribute__((ext_vector_type(2)));
__device__ __forceinline__ f32x2 gelu_pk(f32x2 v) {
    const f32x2 av = __builtin_elementwise_abs(v), d = av * 0.2316418882f + 1.0f;
    f32x2 t; t.x = __builtin_amdgcn_rcpf(d.x); t.y = __builtin_amdgcn_rcpf(d.y);
    f32x2 q = t * 0.5307027145f + (-0.7265760135f); q = q * t + 0.7107068705f; q = q * t + (-0.142248368f); q = q * t + 0.127414796f; q = q * t;
    const f32x2 s = (v * v) * (-0.72134752044f);
    f32x2 e; e.x = __builtin_amdgcn_exp2f(s.x); e.y = __builtin_amdgcn_exp2f(s.y);
    const f32x2 m = v * (q * e), r = v - m;
    f32x2 o; o.x = v.x < 0.f ? m.x : r.x; o.y = v.y < 0.f ? m.y : r.y; return o;
}

template <int ACT  > struct EpiBf16 {
    static constexpr bool PERM = true, AFTER_DRAIN = false; static_assert(ACT == 0 || ACT == 1, "EpiBf16: ACT is 0 (none) or 1 (gelu_pk)");
    bf16_t* O; int ldc; const float* bias; int split_cols; size_t split_stride; float scale0;
    __device__ __forceinline__ void operator()(const f32x4 (&acc)[2][2][4][2], const Unit& u, int wr, int wc, int fr, int fq) const {
        const int row0 = u.pm * BM + wr * 64 + fr; int colt = u.pn * BM; bf16_t* base = O;
        float sc = 1.f; if (split_cols) { const int t = colt / split_cols; base += (size_t)t * split_stride; colt -= t * split_cols; if (t == 0) sc = scale0; }
        const int col0 = colt + wc * 32 + 8 * fq, bcol0 = u.pn * BM + wc * 32 + 8 * fq;
        f32x4 bv[2][2];
#pragma unroll
        for (int bj = 0; bj < 2; ++bj)
#pragma unroll
            for (int n = 0; n < 2; ++n) bv[bj][n] = bias ? *(const f32x4*)(bias + bcol0 + bj * HALF + 4 * n) : (f32x4){0.f, 0.f, 0.f, 0.f};
#pragma unroll
        for (int ai = 0; ai < 2; ++ai)
#pragma unroll
            for (int m = 0; m < 4; ++m) { bf16_t* rowp = base + (size_t)(row0 + ai * HALF + m * 16) * ldc + col0;
#pragma unroll
                for (int bj = 0; bj < 2; ++bj) { f32x4 v0 = acc[ai][bj][m][0] + bv[bj][0], v1 = acc[ai][bj][m][1] + bv[bj][1];
                    if (ACT == 1) { f32x2 a = gelu_pk((f32x2){v0[0], v0[1]}), b = gelu_pk((f32x2){v0[2], v0[3]}), c = gelu_pk((f32x2){v1[0], v1[1]}), d = gelu_pk((f32x2){v1[2], v1[3]});
                        v0 = (f32x4){a.x, a.y, b.x, b.y}; v1 = (f32x4){c.x, c.y, d.x, d.y}; }
                    v0 = v0 * sc; v1 = v1 * sc; u32x4 w; w.x = cvt_pk_bf16(v0[0], v0[1]); w.y = cvt_pk_bf16(v0[2], v0[3]); w.z = cvt_pk_bf16(v1[0], v1[1]); w.w = cvt_pk_bf16(v1[2], v1[3]);
                    *(u32x4*)(rowp + bj * HALF) = w; } }
    }
};

struct EpiBf16S {
    static constexpr bool PERM = true, AFTER_DRAIN = false;
    bf16_t* O; int ldc; float scale;
    __device__ __forceinline__ void operator()(const f32x4 (&acc)[2][2][4][2], const Unit& u, int wr, int wc, int fr, int fq) const {
        const int row0 = u.pm * BM + wr * 64 + fr, col0 = u.pn * BM + wc * 32 + 8 * fq;
#pragma unroll
        for (int ai = 0; ai < 2; ++ai)
#pragma unroll
            for (int m = 0; m < 4; ++m) { bf16_t* rowp = O + (size_t)(row0 + ai * HALF + m * 16) * ldc + col0;
#pragma unroll
                for (int bj = 0; bj < 2; ++bj) { const f32x4 v0 = acc[ai][bj][m][0] * scale, v1 = acc[ai][bj][m][1] * scale;
                    u32x4 w; w.x = cvt_pk_bf16(v0[0], v0[1]); w.y = cvt_pk_bf16(v0[2], v0[3]); w.z = cvt_pk_bf16(v1[0], v1[1]); w.w = cvt_pk_bf16(v1[2], v1[3]);
                    *(u32x4*)(rowp + bj * HALF) = w; } }
    }
};
struct EpiGlaIn {
    static constexpr bool PERM = true, AFTER_DRAIN = false;
    bf16_t* O; float* glr; float qscale;
    __device__ __forceinline__ void operator()(const f32x4 (&acc)[2][2][4][2], const Unit& u, int wr, int wc, int fr, int fq) const {
        const int row0 = u.pm * BM + wr * 64 + fr;
        if (u.pn < 12) {
            const float sc = (u.pn < 2) ? qscale : 1.f; const int col0 = u.pn * BM + wc * 32 + 8 * fq;
#pragma unroll
            for (int ai = 0; ai < 2; ++ai)
#pragma unroll
                for (int m = 0; m < 4; ++m) { bf16_t* rowp = O + (size_t)(row0 + ai * HALF + m * 16) * 3072 + col0;
#pragma unroll
                    for (int bj = 0; bj < 2; ++bj) { const f32x4 v0 = acc[ai][bj][m][0] * sc, v1 = acc[ai][bj][m][1] * sc;
                        u32x4 w; w.x = cvt_pk_bf16(v0[0], v0[1]); w.y = cvt_pk_bf16(v0[2], v0[3]); w.z = cvt_pk_bf16(v1[0], v1[1]); w.w = cvt_pk_bf16(v1[2], v1[3]);
                        *(u32x4*)(rowp + bj * HALF) = w; } }
        } else if (wc == 0 && fq < 2) {
#pragma unroll
            for (int ai = 0; ai < 2; ++ai)
#pragma unroll
                for (int m = 0; m < 4; ++m) { float* p = glr + (size_t)(row0 + ai * HALF + m * 16) * 16 + 8 * fq; *(f32x4*)p = acc[ai][0][m][0]; *(f32x4*)(p + 4) = acc[ai][0][m][1]; }
        }
    }
};
struct EpiResid {
    static constexpr bool PERM = true, AFTER_DRAIN = false;
    const float* xin; float* out; const float* gate; float alpha;
    __device__ __forceinline__ void operator()(const f32x4 (&acc)[2][2][4][2], const Unit& u, int wr, int wc, int fr, int fq) const {
        const int row0 = u.pm * BM + wr * 64 + fr, col0 = u.pn * BM + wc * 32 + 8 * fq;
        const float* gp = gate + (size_t)(u.pm >> 5) * 6144 + col0;
#pragma unroll
        for (int ai = 0; ai < 2; ++ai)
#pragma unroll
            for (int m = 0; m < 4; ++m) { const size_t off = (size_t)(row0 + ai * HALF + m * 16) * 1024 + col0;
#pragma unroll
                for (int bj = 0; bj < 2; ++bj)
#pragma unroll
                    for (int n = 0; n < 2; ++n) { const f32x4 xv = *(const f32x4*)(xin + off + bj * HALF + 4 * n); const f32x4 gv = *(const f32x4*)(gp + bj * HALF + 4 * n) + 1.0f;
                        *(f32x4*)(out + off + bj * HALF + 4 * n) = xv * alpha + gv * acc[ai][bj][m][n]; }
                asm volatile("" ::: "memory"); }
    }
};
struct EpiSwiglu {
    static constexpr bool PERM = true, AFTER_DRAIN = false;
    bf16_t* O; int ldc;
    __device__ __forceinline__ static float sw(float g, float uu) { return g * __builtin_amdgcn_rcpf(1.0f + __builtin_amdgcn_exp2f(-1.4426950408889634f * g)) * uu; }
    __device__ __forceinline__ void operator()(const f32x4 (&acc)[2][2][4][2], const Unit& u, int wr, int wc, int fr, int fq) const {
        const int row0 = u.pm * BM + wr * 64 + fr, col0 = u.pn * HALF + wc * 32 + 8 * fq;
#pragma unroll
        for (int ai = 0; ai < 2; ++ai)
#pragma unroll
            for (int m = 0; m < 4; ++m) { bf16_t* rowp = O + (size_t)(row0 + ai * HALF + m * 16) * ldc + col0;
                const f32x4 g0 = acc[ai][0][m][0], g1 = acc[ai][0][m][1], u0 = acc[ai][1][m][0], u1 = acc[ai][1][m][1];
                u32x4 w; w.x = cvt_pk_bf16(sw(g0[0], u0[0]), sw(g0[1], u0[1])); w.y = cvt_pk_bf16(sw(g0[2], u0[2]), sw(g0[3], u0[3]));
                w.z = cvt_pk_bf16(sw(g1[0], u1[0]), sw(g1[1], u1[1])); w.w = cvt_pk_bf16(sw(g1[2], u1[2]), sw(g1[3], u1[3]));
                *(u32x4*)rowp = w; }
    }
};

template <class Epi, class Sched, bool ALIGN_EPI = false, bool SP2 = false>
__device__ __forceinline__ void gemm_phase(PG8_LAS unsigned char* lds, const Gemm g, const Sched& S, const Epi& E, const int tid) {
    const int wid = __builtin_amdgcn_readfirstlane(tid >> 6), lane = tid & 63, wr = wid >> 2, wc = wid & 3, fr = lane & 15, fq = lane >> 4;
    const int K = g.K, nt = K / BK;
    unsigned voffA[2], voffB[2];
#pragma unroll
    for (int i = 0; i < 2; ++i) { int R, C; stage_rc(tid * 16 + i * 8192, R, C); const int Rb = Epi::PERM ? ((R & ~31) + perm32(R & 31)) : R;
        voffA[i] = (unsigned)(R * K + C) * 2u; voffB[i] = (unsigned)(Rb * K + C) * 2u; }
    const size_t kstep = (size_t)(BK * 2);
    const size_t hstep = (size_t)HALF * K * 2;
    const size_t tstep = 2 * hstep;
    const unsigned ldsw = (unsigned)wid * 1024u;
    const int aoff = lds_byte(wr * 64 + fr, fq * 8), boff = lds_byte(wc * 32 + fr, fq * 8);
#define PG8_SA(b, h) (((b) * 2 + (h)) * HTB)
#define PG8_SB(b, h) ((4 + (b) * 2 + (h)) * HTB)
#define PG8_STAGE(bufoff, gbase, voff) do { _Pragma("unroll") for (int _i = 0; _i < 2; ++_i) \
        __builtin_amdgcn_global_load_lds((const unsigned*)((const char*)(gbase) + (voff)[_i]), (PG8_LAS unsigned*)(lds + (bufoff) + ldsw + _i * 8192), 16, 0, 0); } while (0)
#define PG8_LDA(dst, b, h) do { _Pragma("unroll") for (int m = 0; m < 4; ++m) _Pragma("unroll") for (int k = 0; k < 2; ++k) dst[m][k] = *(const PG8_LAS bf16x8*)(lds + PG8_SA(b, h) + aoff + m * 2048 + k * 1024); } while (0)
#define PG8_LDB(dst, b, h) do { _Pragma("unroll") for (int n = 0; n < 2; ++n) _Pragma("unroll") for (int k = 0; k < 2; ++k) dst[n][k] = *(const PG8_LAS bf16x8*)(lds + PG8_SB(b, h) + boff + n * 2048 + k * 1024); } while (0)
#define PG8_MMA(ai, bj, At, Bt) do { __builtin_amdgcn_s_setprio(1); _Pragma("unroll") for (int m = 0; m < 4; ++m) _Pragma("unroll") for (int n = 0; n < 2; ++n) _Pragma("unroll") for (int k = 0; k < 2; ++k) \
        acc[ai][bj][m][n] = __builtin_amdgcn_mfma_f32_16x16x32_bf16(Bt[n][k], At[m][k], acc[ai][bj][m][n], 0, 0, 0); __builtin_amdgcn_s_setprio(0); } while (0)
#define PG8_WAIT_V(n) asm volatile("s_waitcnt vmcnt(" #n ")" ::: "memory")
#define PG8_WAIT_L(n) asm volatile("s_waitcnt lgkmcnt(" #n ")" ::: "memory")
#define PG8_BAR __builtin_amdgcn_s_barrier()
#define PG8_SCHED __builtin_amdgcn_sched_barrier(0)
    Unit cur, nxt; int ui = 0;
    if (!S.next(0, cur)) return;
    f32x4 acc[2][2][4][2];
#pragma unroll
    for (int a = 0; a < 2; ++a)
#pragma unroll
        for (int b = 0; b < 2; ++b)
#pragma unroll
            for (int m = 0; m < 4; ++m)
#pragma unroll
                for (int n = 0; n < 2; ++n) acc[a][b][m][n] = (f32x4){0.f, 0.f, 0.f, 0.f};
    bf16x8 At[4][2], B0[2][2], B1[2][2];
    const char* cA = (const char*)g.A + (size_t)cur.pm * tstep; const char* cB = (const char*)g.Bt + (size_t)cur.pn * tstep;
    S.a_ready(cur);
    if constexpr (SP2) {
        PG8_STAGE(PG8_SB(0, 0), cB, voffB); PG8_STAGE(PG8_SB(0, 1), cB + hstep, voffB); PG8_STAGE(PG8_SA(0, 0), cA, voffA); PG8_STAGE(PG8_SA(0, 1), cA + hstep, voffA);
        if (wr == 1) PG8_BAR;
        PG8_WAIT_V(2); PG8_BAR;
        PG8_STAGE(PG8_SB(1, 0), cB + kstep, voffB); PG8_STAGE(PG8_SA(1, 0), cA + kstep, voffA); PG8_STAGE(PG8_SB(1, 1), cB + hstep + kstep, voffB);
        PG8_WAIT_V(6); PG8_BAR;
    } else {
        PG8_STAGE(PG8_SB(0, 0), cB, voffB); PG8_STAGE(PG8_SA(0, 0), cA, voffA); PG8_STAGE(PG8_SB(0, 1), cB + hstep, voffB); PG8_STAGE(PG8_SA(0, 1), cA + hstep, voffA);
        if (wr == 1) PG8_BAR;
        PG8_WAIT_V(4); PG8_BAR;
        PG8_STAGE(PG8_SB(1, 0), cB + kstep, voffB); PG8_STAGE(PG8_SA(1, 0), cA + kstep, voffA); PG8_STAGE(PG8_SB(1, 1), cB + hstep + kstep, voffB);
        PG8_WAIT_V(6); PG8_BAR;
    }
    for (;;) {
        const bool has_next = S.next(ui + 1, nxt);
        const char* nA = has_next ? (const char*)g.A + (size_t)nxt.pm * tstep : cA; const char* nB = has_next ? (const char*)g.Bt + (size_t)nxt.pn * tstep : cB;
        for (int t = 0; t < nt; t += 2) {
            const bool last = (t == nt - 2);
            const char* a1 = cA + (size_t)(t + 1) * kstep;
            const char* a2 = last ? nA : cA + (size_t)(t + 2) * kstep; const char* b2 = last ? nB : cB + (size_t)(t + 2) * kstep;
            const char* a3 = a2 + kstep; const char* b3 = b2 + kstep;
            if (last && has_next) S.a_ready(nxt);
            if constexpr (SP2) {
            PG8_LDB(B0, 0, 0); PG8_LDB(B1, 0, 1); PG8_SCHED; PG8_LDA(At, 0, 0); PG8_STAGE(PG8_SA(1, 1), a1 + hstep, voffA);
            PG8_WAIT_V(8); PG8_WAIT_L(0); PG8_BAR; PG8_MMA(0, 0, At, B0); PG8_MMA(0, 1, At, B1); PG8_BAR; PG8_SCHED;
            PG8_LDA(At, 0, 1); PG8_STAGE(PG8_SB(0, 0), b2, voffB); PG8_STAGE(PG8_SB(0, 1), b2 + hstep, voffB); PG8_STAGE(PG8_SA(0, 0), a2, voffA);
            PG8_WAIT_V(8); PG8_WAIT_L(0); PG8_BAR; PG8_MMA(1, 0, At, B0); PG8_MMA(1, 1, At, B1); PG8_BAR; PG8_SCHED;
            PG8_LDB(B0, 1, 0); PG8_LDB(B1, 1, 1); PG8_SCHED; PG8_LDA(At, 1, 0); PG8_STAGE(PG8_SA(0, 1), a2 + hstep, voffA);
            PG8_WAIT_V(8); PG8_WAIT_L(0); PG8_BAR; PG8_MMA(0, 0, At, B0); PG8_MMA(0, 1, At, B1); PG8_BAR; PG8_SCHED;
            PG8_LDA(At, 1, 1); PG8_STAGE(PG8_SB(1, 0), b3, voffB); PG8_STAGE(PG8_SB(1, 1), b3 + hstep, voffB); PG8_STAGE(PG8_SA(1, 0), a3, voffA);
            PG8_WAIT_V(8); PG8_WAIT_L(0); PG8_BAR; PG8_MMA(1, 0, At, B0); PG8_MMA(1, 1, At, B1); PG8_BAR; PG8_SCHED;
            } else {
            PG8_LDB(B0, 0, 0); PG8_SCHED; PG8_LDA(At, 0, 0); PG8_STAGE(PG8_SA(1, 1), a1 + hstep, voffA);
            PG8_WAIT_L(8); PG8_BAR; PG8_WAIT_L(0); PG8_MMA(0, 0, At, B0); PG8_BAR; PG8_SCHED;
            PG8_LDB(B1, 0, 1); PG8_STAGE(PG8_SB(0, 0), b2, voffB);
            PG8_BAR; PG8_WAIT_L(0); PG8_MMA(0, 1, At, B1); PG8_BAR;
            PG8_LDA(At, 0, 1); PG8_STAGE(PG8_SA(0, 0), a2, voffA);
            PG8_BAR; PG8_WAIT_L(0); PG8_MMA(1, 0, At, B0); PG8_BAR; PG8_SCHED;
            PG8_STAGE(PG8_SB(0, 1), b2 + hstep, voffB);
            PG8_WAIT_V(6); PG8_BAR; PG8_MMA(1, 1, At, B1); PG8_BAR;
            PG8_LDB(B0, 1, 0); PG8_SCHED; PG8_LDA(At, 1, 0); PG8_STAGE(PG8_SA(0, 1), a2 + hstep, voffA);
            PG8_WAIT_L(8); PG8_BAR; PG8_WAIT_L(0); PG8_MMA(0, 0, At, B0); PG8_BAR; PG8_SCHED;
            PG8_LDB(B1, 1, 1); PG8_STAGE(PG8_SB(1, 0), b3, voffB);
            PG8_BAR; PG8_WAIT_L(0); PG8_MMA(0, 1, At, B1); PG8_BAR;
            PG8_LDA(At, 1, 1); PG8_STAGE(PG8_SA(1, 0), a3, voffA);
            PG8_BAR; PG8_WAIT_L(0); PG8_MMA(1, 0, At, B0); PG8_BAR; PG8_SCHED;
            PG8_STAGE(PG8_SB(1, 1), b3 + hstep, voffB);
            PG8_WAIT_V(6); PG8_BAR; PG8_MMA(1, 1, At, B1); PG8_BAR;
            }
        }
        if constexpr (ALIGN_EPI) { if (wr == 0) PG8_BAR; }
        if constexpr (!Epi::AFTER_DRAIN) { E(acc, cur, wr, wc, fr, fq); S.done(cur); }
        if (!has_next) break;
#pragma unroll
        for (int a = 0; a < 2; ++a)
#pragma unroll
            for (int b = 0; b < 2; ++b)
#pragma unroll
                for (int m = 0; m < 4; ++m)
#pragma unroll
                    for (int n = 0; n < 2; ++n) acc[a][b][m][n] = (f32x4){0.f, 0.f, 0.f, 0.f};
        cur = nxt; cA = nA; cB = nB; ++ui;
        if constexpr (ALIGN_EPI) { if (wr == 1) PG8_BAR; }
    }
    PG8_WAIT_V(0);
    if constexpr (!ALIGN_EPI) { if (wr == 0) PG8_BAR; }
    PG8_BAR;
    if constexpr (Epi::AFTER_DRAIN) { E.fused(acc, cur, wr, wc, fr, fq, lds, wid, lane); S.done(cur); }
#undef PG8_SA
#undef PG8_SB
#undef PG8_STAGE
#undef PG8_LDA
#undef PG8_LDB
#undef PG8_MMA
#undef PG8_WAIT_V
#undef PG8_WAIT_L
#undef PG8_BAR
#undef PG8_SCHED
}
}

#ifndef PG8_SP2
#define PG8_SP2 true
#endif
#ifndef PG8_ALIGN
#define PG8_ALIGN true
#endif
#include <hip/hip_cooperative_groups.h>
namespace cg = cooperative_groups;

#ifndef MK_PER_PHASE
#define MK_PER_PHASE 0
#endif
constexpr int NWAVES = 8, NTHREADS = 512;
constexpr int NB = 8, SEQ = 8192, D = 1024, M = NB * SEQ, DEPTH = 4;
constexpr int GIN_N = 3088, GIN_NP = 3328, FF = 2816;
constexpr float ALPHA = 1.6817928305074290f;
constexpr float LN_EPS = 1e-5f, RMS_EPS = 1e-5f;
constexpr float LOG2E = 1.4426950408889634f;

constexpr size_t MiB = 1u << 20;
constexpr size_t WS_MOD = 1 * MiB;
constexpr size_t WS_KVMOD = WS_MOD + (size_t)4 * 8 * 6144 * 4;
constexpr size_t WS_GLR = 2 * MiB;
constexpr size_t WS_WGIN = 6 * MiB;
constexpr size_t WS_WGOUT = 19 * MiB;
constexpr size_t WS_WDQ = 23 * MiB;
constexpr size_t WS_WDOUT = 35 * MiB;
constexpr size_t WS_WKV = 39 * MiB;
constexpr size_t WS_WFIN = 43 * MiB;
constexpr size_t WS_WFOUT = 87 * MiB;
constexpr size_t WS_ML = 110 * MiB;
constexpr size_t WS_H = 136 * MiB;
constexpr size_t WS_BIG = 264 * MiB;
constexpr size_t WS_O = 648 * MiB;
constexpr size_t WS_V = 776 * MiB;
constexpr size_t WS_END = 904 * MiB;

constexpr int RING_BYTES = 131072, LDS_BYTES = 147456;

#define GAS __attribute__((address_space(1)))
#define LAS __attribute__((address_space(3)))
typedef unsigned short bf16;
typedef unsigned v4u __attribute__((ext_vector_type(4)));
typedef unsigned v2u __attribute__((ext_vector_type(2)));
typedef float f32x4 __attribute__((ext_vector_type(4)));
typedef float f32x2 __attribute__((ext_vector_type(2)));
typedef float f32x16 __attribute__((ext_vector_type(16)));
typedef short bf16x8 __attribute__((ext_vector_type(8)));
typedef short s16x4 __attribute__((ext_vector_type(4)));
#define LDS_WAIT() asm volatile("s_waitcnt lgkmcnt(0)" ::: "memory")
#define LBAR() asm volatile("s_waitcnt lgkmcnt(0)\n\ts_barrier" ::: "memory")
typedef __bf16 bf16x2_t __attribute__((ext_vector_type(2)));
__device__ __forceinline__ unsigned pk2(float lo, float hi) { f32x2 v = {lo, hi}; bf16x2_t b = __builtin_convertvector(v, bf16x2_t); return __builtin_bit_cast(unsigned, b); }
__device__ __forceinline__ float bflo(unsigned u) { return __uint_as_float(u << 16); }
__device__ __forceinline__ float bfhi(unsigned u) { return __uint_as_float(u & 0xffff0000u); }
__device__ __forceinline__ float ex2(float x) { return __builtin_amdgcn_exp2f(x); }

struct Frame {
    LAS unsigned char* lds;
    int tid, lane, wave, vcu, G, bid;
    float* out; unsigned char* ws;
};
constexpr int PTAB_OFF = RING_BYTES + 1024;
enum { I_X = 0, I_C, I_GLA_W_IN, I_GLA_W_GATE_UP, I_GLA_B_GATE, I_GLA_NORM_G, I_GLA_W_OUT, I_DIL_W_Q, I_DIL_W_OUT, I_KV_ADA_W, I_KV_ADA_B, I_W_KV, I_FFN_W_IN, I_FFN_W_OUT, I_ADA_W, I_ADA_B, I_LN_G, I_LN_B };
__device__ __forceinline__ const float* inp(const Frame& F, int i) {
    const LAS unsigned* p = (const LAS unsigned*)(F.lds + PTAB_OFF + 8 * i);
    const unsigned lo = __builtin_amdgcn_readfirstlane(p[0]), hi = __builtin_amdgcn_readfirstlane(p[1]);
    return (const float*)(((unsigned long long)hi << 32) | lo);
}

__device__ __forceinline__ Frame launder(const Frame& F) {
    Frame P = F;
    asm volatile("" : "+v"(P.tid));
    P.lane = P.tid & 63; P.wave = __builtin_amdgcn_readfirstlane(P.tid >> 6);
    asm volatile("" : "+s"(P.vcu), "+s"(P.G), "+s"(P.bid));
    asm volatile("" : "+s"(P.out), "+s"(P.ws));
    asm volatile("" : "+s"(P.lds));
    return P;
}
__device__ __forceinline__ void p0_item(const float* W, int K, int N, bf16* WT, int mode, LAS float* scr, int item, int lane) {
    const int nblk = (N + 31) >> 5, kb = item / nblk, nb = item - kb * nblk, k0 = 64 * kb, n0 = 32 * nb;
    int d0 = n0;
    if (mode == 1) { const int s = nb / 88, wi = nb - s * 88, j0 = 32 * wi; d0 = 256 * (j0 >> 7) + 128 * s + (j0 & 127); }
    const bool okc = (n0 + (lane & 31)) < N;
#pragma unroll 8
    for (int i = 0; i < 32; ++i) { const int kk = 2 * i + (lane >> 5); scr[kk * 33 + (lane & 31)] = okc ? W[(size_t)(k0 + kk) * N + n0 + (lane & 31)] : 0.f; }
    LDS_WAIT(); asm volatile("" ::: "memory");
    const int c = lane & 7;
#pragma unroll
    for (int j = 0; j < 4; ++j) { const int n = (lane >> 3) + 8 * j; const LAS float* s = scr + (8 * c) * 33 + n;
        v4u o; o.x = pk2(s[0 * 33], s[1 * 33]); o.y = pk2(s[2 * 33], s[3 * 33]); o.z = pk2(s[4 * 33], s[5 * 33]); o.w = pk2(s[6 * 33], s[7 * 33]);
        *(v4u*)(WT + (size_t)(d0 + n) * K + k0 + 8 * c) = o; }
    LDS_WAIT(); asm volatile("" ::: "memory");
}
__device__ __forceinline__ void p0_prologue(Frame& F) {
    {
        LAS float* sc = (LAS float*)F.lds; LAS float* red = (LAS float*)(F.lds + 32768);
        const float* cin = inp(F, I_C);
        for (int i = F.tid; i < NB * D; i += NTHREADS) { const float v = cin[i]; sc[i] = v / (1.0f + __expf(-v)); }
        __syncthreads();
        for (int grp = F.bid; grp < 416; grp += F.G) {
            const float* W; const float* bias; float* outp; int N, n0;
            if (grp < 384) { const int l = grp / 96; n0 = (grp - l * 96) * 64; N = 6144; W = inp(F, I_ADA_W) + (size_t)l * D * 6144; bias = inp(F, I_ADA_B) + l * 6144; outp = (float*)(F.ws + WS_MOD) + (size_t)l * NB * 6144; }
            else { n0 = (grp - 384) * 64; N = 2048; W = inp(F, I_KV_ADA_W); bias = inp(F, I_KV_ADA_B); outp = (float*)(F.ws + WS_KVMOD); }
            float acc[NB];
#pragma unroll
            for (int b = 0; b < NB; ++b) acc[b] = 0.f;
            const float* wp = W + (size_t)(128 * F.wave) * N + n0 + F.lane;
#pragma unroll 8
            for (int kk = 0; kk < 128; ++kk) { const float wv = wp[(size_t)kk * N]; const int k = 128 * F.wave + kk;
#pragma unroll
                for (int b = 0; b < NB; ++b) acc[b] += sc[b * D + k] * wv; }
#pragma unroll
            for (int b = 0; b < NB; ++b) red[(F.wave * NB + b) * 64 + F.lane] = acc[b];
            __syncthreads();
            { const int b = F.wave; float s = bias[n0 + F.lane];
#pragma unroll
              for (int w2 = 0; w2 < NWAVES; ++w2) s += red[(w2 * NB + b) * 64 + F.lane];
              outp[(size_t)b * N + n0 + F.lane] = s; }
            __syncthreads();
        }
    }
    __syncthreads();
    LAS float* scr = (LAS float*)(F.lds + F.wave * 16384);
    const int gw = F.vcu * NWAVES + F.wave, NGW = F.G * NWAVES;
    constexpr int I_GIN = 16 * 97, I_SQ = 16 * 32, I_DQ = 16 * 96, I_KV = 16 * 64, I_FIN = 16 * 176, I_FOUT = 44 * 32;
    constexpr int NITEMS = 2 * I_GIN + 2 * I_SQ + 2 * I_DQ + 2 * I_SQ + I_KV + 4 * I_FIN + 4 * I_FOUT;
    for (int it = gw; it < NITEMS; it += NGW) {
        int r = it;
        if (r < 2 * I_GIN) { const int l = r / I_GIN; p0_item(inp(F, I_GLA_W_IN) + (size_t)l * D * GIN_N, D, GIN_N, (bf16*)(F.ws + WS_WGIN) + (size_t)l * GIN_NP * D, 0, scr, r - l * I_GIN, F.lane); continue; } r -= 2 * I_GIN;
        if (r < 2 * I_SQ) { const int l = r / I_SQ; p0_item(inp(F, I_GLA_W_OUT) + (size_t)l * D * D, D, D, (bf16*)(F.ws + WS_WGOUT) + (size_t)l * D * D, 0, scr, r - l * I_SQ, F.lane); continue; } r -= 2 * I_SQ;
        if (r < 2 * I_DQ) { const int l = r / I_DQ; p0_item(inp(F, I_DIL_W_Q) + (size_t)l * D * 3072, D, 3072, (bf16*)(F.ws + WS_WDQ) + (size_t)l * 3072 * D, 0, scr, r - l * I_DQ, F.lane); continue; } r -= 2 * I_DQ;
        if (r < 2 * I_SQ) { const int l = r / I_SQ; p0_item(inp(F, I_DIL_W_OUT) + (size_t)l * D * D, D, D, (bf16*)(F.ws + WS_WDOUT) + (size_t)l * D * D, 0, scr, r - l * I_SQ, F.lane); continue; } r -= 2 * I_SQ;
        if (r < I_KV) { p0_item(inp(F, I_W_KV), D, 2048, (bf16*)(F.ws + WS_WKV), 0, scr, r, F.lane); continue; } r -= I_KV;
        if (r < 4 * I_FIN) { const int l = r / I_FIN; p0_item(inp(F, I_FFN_W_IN) + (size_t)l * D * 2 * FF, D, 2 * FF, (bf16*)(F.ws + WS_WFIN) + (size_t)l * 2 * FF * D, 1, scr, r - l * I_FIN, F.lane); continue; } r -= 4 * I_FIN;
        { const int l = r / I_FOUT; p0_item(inp(F, I_FFN_W_OUT) + (size_t)l * FF * D, FF, D, (bf16*)(F.ws + WS_WFOUT) + (size_t)l * D * FF, 0, scr, r - l * I_FOUT, F.lane); }
    }
}

__device__ __forceinline__ float wave_sum(float v) {
#pragma unroll
    for (int o = 1; o < 64; o <<= 1) v += __shfl_xor(v, o);
    return v;
}
template <bool DO_LN, bool WRITE_X, int NOUT>
__device__ __forceinline__ void row_pass(Frame& F, const float* zin, float* xout, const float* lng, const float* lnb,
                                         const float* shA, const float* scA, bf16* hA, const float* shB, const float* scB, bf16* hB) {
    const int gw = F.vcu * NWAVES + F.wave; const int rpw = M / (F.G * NWAVES);
    const int r0 = gw * rpw; const int b = r0 / SEQ;
    const int cb = 4 * F.lane;
    f32x4 g[4], bb[4], s1A[4], shAv[4], s1B[4], shBv[4];
#pragma unroll
    for (int j = 0; j < 4; ++j) {
        if (DO_LN) { g[j] = *(const f32x4*)(lng + cb + 256 * j); bb[j] = *(const f32x4*)(lnb + cb + 256 * j); }
        if (NOUT >= 1) { s1A[j] = *(const f32x4*)(scA + cb + 256 * j) + 1.0f; shAv[j] = *(const f32x4*)(shA + cb + 256 * j); }
        if (NOUT >= 2) { s1B[j] = *(const f32x4*)(scB + cb + 256 * j) + 1.0f; shBv[j] = *(const f32x4*)(shB + cb + 256 * j); }
    }
    (void)b;
    for (int r = r0; r < r0 + rpw; ++r) {
        const float* zr = zin + (size_t)r * D + cb;
        f32x4 v[4];
#pragma unroll
        for (int j = 0; j < 4; ++j) v[j] = *(const f32x4*)(zr + 256 * j);
        if (DO_LN) {
            float s = 0.f;
#pragma unroll
            for (int j = 0; j < 4; ++j) s += (v[j].x + v[j].y) + (v[j].z + v[j].w);
            const float mean = wave_sum(s) * (1.f / D); float s2 = 0.f;
#pragma unroll
            for (int j = 0; j < 4; ++j) { v[j] = v[j] - mean; s2 += (v[j].x * v[j].x + v[j].y * v[j].y) + (v[j].z * v[j].z + v[j].w * v[j].w); }
            const float rstd = 1.f / sqrtf(wave_sum(s2) * (1.f / D) + LN_EPS);
#pragma unroll
            for (int j = 0; j < 4; ++j) v[j] = v[j] * rstd * g[j] + bb[j];
        }
        if (WRITE_X) {
            float* xr = xout + (size_t)r * D + cb;
#pragma unroll
            for (int j = 0; j < 4; ++j) *(f32x4*)(xr + 256 * j) = v[j];
        }
        if (NOUT >= 1) {
            bf16* hr = hA + (size_t)r * D + cb;
#pragma unroll
            for (int j = 0; j < 4; ++j) { const f32x4 o = v[j] * s1A[j] + shAv[j]; v2u w; w.x = pk2(o.x, o.y); w.y = pk2(o.z, o.w); *(v2u*)(hr + 256 * j) = w; }
        }
        if (NOUT >= 2) {
            bf16* hr = hB + (size_t)r * D + cb;
#pragma unroll
            for (int j = 0; j < 4; ++j) { const f32x4 o = v[j] * s1B[j] + shBv[j]; v2u w; w.x = pk2(o.x, o.y); w.y = pk2(o.z, o.w); *(v2u*)(hr + 256 * j) = w; }
        }
    }
}

constexpr int GL_GLR = 0, GL_VT = 4096, GL_TOT = GL_VT + 32 * 144, GL_DEC = GL_TOT + 4096, GL_QE = GL_DEC + 512, GL_KE = GL_QE + 64 * 272, GL_KDT = GL_KE + 64 * 272,
              GL_P = GL_KDT + 128 * 144, GL_ST = GL_P + 64 * 144, GL_END = GL_ST + 32 * 272;
static_assert(GL_END <= RING_BYTES, "GLA LDS map");
__device__ __forceinline__ float logsig2(float z) {
    const float az = __builtin_fabsf(z);
    const float t = __builtin_amdgcn_exp2f(-az * LOG2E);
    const float l2 = __builtin_amdgcn_logf(1.0f + t);
    return (fminf(z, 0.f) * LOG2E - l2) * (1.0f / 16.0f);
}
__device__ __forceinline__ void gla_phase(Frame& F, int l) {
    LAS unsigned char* lds = F.lds;
    const int tid = F.tid, lane = F.lane, w = F.wave, fr = lane & 15, quad = lane >> 4;
    const bf16* QKVR = (const bf16*)(F.ws + WS_BIG); const float* GLR = (const float*)(F.ws + WS_GLR); bf16* OB = (bf16*)(F.ws + WS_O);
    for (int unit = F.vcu; unit < 256; unit += F.G) {
        const int bh = unit >> 3, sl = unit & 7, b = bh >> 2, h = bh & 3;
        float wg0[16], wg1[16];
        { const float* wgp = inp(F, I_GLA_W_GATE_UP) + (size_t)l * 16 * 512 + h * 128 + 2 * lane;
#pragma unroll
          for (int r = 0; r < 16; ++r) { const f32x2 t = *(const f32x2*)(wgp + r * 512); wg0[r] = t.x; wg1[r] = t.y; } }
        const f32x2 bgv = *(const f32x2*)(inp(F, I_GLA_B_GATE) + l * 512 + h * 128 + 2 * lane);
        f32x4 st[2]; st[0] = (f32x4){0.f, 0.f, 0.f, 0.f}; st[1] = st[0];
        for (int i = tid; i < 32 * 272 / 4; i += NTHREADS) ((LAS unsigned*)(lds + GL_ST))[i] = 0u;
        const size_t rowb = (size_t)b * SEQ;
        const bf16* qsrc = QKVR + (rowb + 8 * w) * 3072 + h * 128 + 2 * lane;
        const float* gsrc = GLR + (rowb + (tid >> 3)) * 16 + 2 * (tid & 7);
        const bf16* vsrc = QKVR + (rowb + (tid >> 3)) * 3072 + 1024 + h * 256 + sl * 32 + 4 * (tid & 7);
        unsigned qn[8], kn[8]; f32x2 gn; v2u vn;
#pragma unroll
        for (int i = 0; i < 8; ++i) { qn[i] = *(const unsigned*)(qsrc + (size_t)i * 3072); kn[i] = *(const unsigned*)(qsrc + (size_t)i * 3072 + 512); }
        gn = *(const f32x2*)gsrc; vn = *(const v2u*)vsrc;
        for (int c = 0; c < SEQ / 64; ++c) {
            unsigned qc[8], kc[8];
#pragma unroll
            for (int i = 0; i < 8; ++i) { qc[i] = qn[i]; kc[i] = kn[i]; }
            *(LAS f32x2*)(lds + GL_GLR + (tid >> 3) * 64 + (tid & 7) * 8) = gn;
            { const int t = tid >> 3, w4 = 4 * (tid & 7); LAS bf16* vt = (LAS bf16*)(lds + GL_VT);
              vt[(w4 + 0) * 72 + t] = (bf16)(vn.x & 0xffffu); vt[(w4 + 1) * 72 + t] = (bf16)(vn.x >> 16); vt[(w4 + 2) * 72 + t] = (bf16)(vn.y & 0xffffu); vt[(w4 + 3) * 72 + t] = (bf16)(vn.y >> 16); }
            LBAR();
            float bl0[8], bl1[8];
            { float r0 = 0.f, r1 = 0.f;
#pragma unroll
              for (int i = 0; i < 8; ++i) {
                const LAS f32x4* gp = (const LAS f32x4*)(lds + GL_GLR + (8 * w + i) * 64);
                float z0 = bgv.x, z1 = bgv.y;
#pragma unroll
                for (int r4 = 0; r4 < 4; ++r4) { const f32x4 gvv = gp[r4];
                    z0 += gvv.x * wg0[4 * r4] + gvv.y * wg0[4 * r4 + 1] + gvv.z * wg0[4 * r4 + 2] + gvv.w * wg0[4 * r4 + 3];
                    z1 += gvv.x * wg1[4 * r4] + gvv.y * wg1[4 * r4 + 1] + gvv.z * wg1[4 * r4 + 2] + gvv.w * wg1[4 * r4 + 3]; }
                r0 += logsig2(z0); r1 += logsig2(z1); bl0[i] = r0; bl1[i] = r1; }
              *(LAS f32x2*)(lds + GL_TOT + (w * 128 + 2 * lane) * 4) = (f32x2){r0, r1}; }
            LBAR();
            { float off0 = 0.f, off1 = 0.f, all0 = 0.f, all1 = 0.f;
#pragma unroll
              for (int w2 = 0; w2 < 8; ++w2) { const f32x2 t = *(const LAS f32x2*)(lds + GL_TOT + (w2 * 128 + 2 * lane) * 4); all0 += t.x; all1 += t.y; if (w2 < w) { off0 += t.x; off1 += t.y; } }
              unsigned kd0[4], kd1[4];
#pragma unroll
              for (int i = 0; i < 8; ++i) {
                const float b0 = off0 + bl0[i], b1 = off1 + bl1[i];
                const float e0 = ex2(b0), e1 = ex2(b1), n0 = ex2(-b0), n1 = ex2(-b1), d0 = ex2(all0 - b0), d1 = ex2(all1 - b1);
                const float q0 = bflo(qc[i]), q1 = bfhi(qc[i]), k0 = bflo(kc[i]), k1 = bfhi(kc[i]);
                *(LAS unsigned*)(lds + GL_QE + (8 * w + i) * 272 + lane * 4) = pk2(q0 * e0, q1 * e1);
                *(LAS unsigned*)(lds + GL_KE + (8 * w + i) * 272 + lane * 4) = pk2(k0 * n0, k1 * n1);
                const unsigned p = pk2(k0 * d0, k1 * d1);
                if (i & 1) { kd0[i >> 1] |= (p << 16); kd1[i >> 1] |= (p & 0xffff0000u); } else { kd0[i >> 1] = p & 0xffffu; kd1[i >> 1] = p >> 16; }
              }
              *(LAS v4u*)(lds + GL_KDT + (2 * lane) * 144 + 16 * w) = (v4u){kd0[0], kd0[1], kd0[2], kd0[3]};
              *(LAS v4u*)(lds + GL_KDT + (2 * lane + 1) * 144 + 16 * w) = (v4u){kd1[0], kd1[1], kd1[2], kd1[3]};
              if (w == 0) *(LAS f32x2*)(lds + GL_DEC + 8 * lane) = (f32x2){ex2(all0), ex2(all1)}; }
            if (c + 1 < SEQ / 64) {
                const size_t adv = (size_t)(c + 1) * 64;
#pragma unroll
                for (int i = 0; i < 8; ++i) { qn[i] = *(const unsigned*)(qsrc + (adv + i) * 3072); kn[i] = *(const unsigned*)(qsrc + (adv + i) * 3072 + 512); }
                gn = *(const f32x2*)(gsrc + adv * 16); vn = *(const v2u*)(vsrc + adv * 3072);
            }
            LBAR();
            { const int ib = w >> 1;
#pragma unroll
              for (int jj = 0; jj < 2; ++jj) { const int jb = 2 * (w & 1) + jj;
                f32x4 a = (f32x4){0.f, 0.f, 0.f, 0.f};
                if (jb <= ib) {
#pragma unroll
                    for (int s = 0; s < 4; ++s) { const bf16x8 av = *(const LAS bf16x8*)(lds + GL_KE + (jb * 16 + fr) * 272 + (32 * s + 8 * quad) * 2);
                        const bf16x8 bv = *(const LAS bf16x8*)(lds + GL_QE + (ib * 16 + fr) * 272 + (32 * s + 8 * quad) * 2);
                        a = __builtin_amdgcn_mfma_f32_16x16x32_bf16(av, bv, a, 0, 0, 0); }
                    const int ti = ib * 16 + fr, tj = jb * 16 + 4 * quad;
                    if (tj + 0 > ti) a[0] = 0.f; if (tj + 1 > ti) a[1] = 0.f; if (tj + 2 > ti) a[2] = 0.f; if (tj + 3 > ti) a[3] = 0.f;
                }
                *(LAS v2u*)(lds + GL_P + (ib * 16 + fr) * 144 + (jb * 16 + 4 * quad) * 2) = (v2u){pk2(a[0], a[1]), pk2(a[2], a[3])}; } }
            LBAR();
            { const int wb = w & 1, ib = w >> 1;
              f32x4 o = (f32x4){0.f, 0.f, 0.f, 0.f};
#pragma unroll
              for (int s = 0; s < 2; ++s) { const bf16x8 av = *(const LAS bf16x8*)(lds + GL_VT + (wb * 16 + fr) * 144 + (32 * s + 8 * quad) * 2);
                  const bf16x8 bv = *(const LAS bf16x8*)(lds + GL_P + (ib * 16 + fr) * 144 + (32 * s + 8 * quad) * 2);
                  o = __builtin_amdgcn_mfma_f32_16x16x32_bf16(av, bv, o, 0, 0, 0); }
#pragma unroll
              for (int s = 0; s < 4; ++s) { const bf16x8 av = *(const LAS bf16x8*)(lds + GL_ST + (wb * 16 + fr) * 272 + (32 * s + 8 * quad) * 2);
                  const bf16x8 bv = *(const LAS bf16x8*)(lds + GL_QE + (ib * 16 + fr) * 272 + (32 * s + 8 * quad) * 2);
                  o = __builtin_amdgcn_mfma_f32_16x16x32_bf16(av, bv, o, 0, 0, 0); }
              *(v2u*)(OB + (rowb + (size_t)c * 64 + ib * 16 + fr) * D + h * 256 + sl * 32 + wb * 16 + 4 * quad) = (v2u){pk2(o[0], o[1]), pk2(o[2], o[3])};
              const f32x4 dv = *(const LAS f32x4*)(lds + GL_DEC + (16 * w + 4 * quad) * 4);
#pragma unroll
              for (int cb2 = 0; cb2 < 2; ++cb2) { f32x4 a = st[cb2] * dv;
#pragma unroll
                  for (int s = 0; s < 2; ++s) { const bf16x8 av = *(const LAS bf16x8*)(lds + GL_KDT + (16 * w + fr) * 144 + (32 * s + 8 * quad) * 2);
                      const bf16x8 bv = *(const LAS bf16x8*)(lds + GL_VT + (cb2 * 16 + fr) * 144 + (32 * s + 8 * quad) * 2);
                      a = __builtin_amdgcn_mfma_f32_16x16x32_bf16(av, bv, a, 0, 0, 0); }
                  st[cb2] = a; } }
            LBAR();
#pragma unroll
            for (int cb2 = 0; cb2 < 2; ++cb2) *(LAS v2u*)(lds + GL_ST + (cb2 * 16 + fr) * 272 + (16 * w + 4 * quad) * 2) = (v2u){pk2(st[cb2][0], st[cb2][1]), pk2(st[cb2][2], st[cb2][3])};
        }
        LBAR();
    }
}

__device__ __forceinline__ void gla_gate_pass(Frame& F, int l) {
    const int gw = F.vcu * NWAVES + F.wave; const int rpw = M / (F.G * NWAVES); const int r0 = gw * rpw;
    const bf16* OB = (const bf16*)(F.ws + WS_O); const bf16* RB = (const bf16*)(F.ws + WS_BIG) + 2048; bf16* HB = (bf16*)(F.ws + WS_H);
    const int c0 = 8 * F.lane;
    const float* ng = inp(F, I_GLA_NORM_G) + l * 256 + (c0 & 255);
    const f32x4 ga = *(const f32x4*)ng, gb = *(const f32x4*)(ng + 4);
    for (int r = r0; r < r0 + rpw; ++r) {
#pragma unroll
        for (int hh = 0; hh < 2; ++hh) {
            const v4u ov = *(const v4u*)(OB + (size_t)r * D + 512 * hh + c0), rv = *(const v4u*)(RB + (size_t)r * 3072 + 512 * hh + c0);
            float o[8] = {bflo(ov.x), bfhi(ov.x), bflo(ov.y), bfhi(ov.y), bflo(ov.z), bfhi(ov.z), bflo(ov.w), bfhi(ov.w)};
            float rr[8] = {bflo(rv.x), bfhi(rv.x), bflo(rv.y), bfhi(rv.y), bflo(rv.z), bfhi(rv.z), bflo(rv.w), bfhi(rv.w)};
            float ss = 0.f;
#pragma unroll
            for (int e = 0; e < 8; ++e) ss += o[e] * o[e];
#pragma unroll
            for (int of = 1; of < 32; of <<= 1) ss += __shfl_xor(ss, of);
            const float rs = 1.0f / sqrtf(ss * (1.0f / 256.0f) + RMS_EPS);
            float a[8];
#pragma unroll
            for (int e = 0; e < 8; ++e) { const float gg = e < 4 ? ga[e] : gb[e - 4]; const float sl = rr[e] * __builtin_amdgcn_rcpf(1.0f + ex2(-LOG2E * rr[e])); a[e] = o[e] * rs * gg * sl; }
            *(v4u*)(HB + (size_t)r * D + 512 * hh + c0) = (v4u){pk2(a[0], a[1]), pk2(a[2], a[3]), pk2(a[4], a[5]), pk2(a[6], a[7])};
        }
    }
}

constexpr int DA_K = 0, DA_V = 384 * 144, DA_END = 2 * 384 * 144;
static_assert(DA_END <= RING_BYTES, "attention LDS map");
__device__ __forceinline__ int crow(int r, int hi) { return (r & 3) + 8 * (r >> 2) + 4 * hi; }
__device__ __forceinline__ s16x4 vtr(const LAS unsigned char* p) { return __builtin_bit_cast(s16x4, __builtin_amdgcn_ds_read_tr16_b64_v4i16((LAS s16x4*)p)); }
__device__ __forceinline__ void dil_attn_phase(Frame& F) {
    LAS unsigned char* lds = F.lds;
    const int tid = F.tid, lane = F.lane, w = F.wave, r32 = lane & 31, hi = lane >> 5;
    const bf16* KB = (const bf16*)(F.ws + WS_O); const bf16* VB = (const bf16*)(F.ws + WS_V); bf16* QB = (bf16*)(F.ws + WS_BIG); f32x2* ML = (f32x2*)(F.ws + WS_ML);
    const int per = 12288 / F.G;
    for (int ui = 0; ui < per; ++ui) {
        const int u = F.vcu * per + ui;
        const int bh = u / 96, rem = u - bh * 96, g = rem >> 5, idx = rem & 31;
        const int dil = 1 << (2 * g), lgn = 5 - 2 * g, res = idx >> lgn, blk = idx & ((1 << lgn) - 1);
        const int b = bh >> 4, h = bh & 15, i0 = blk * 256;
        { v4u kr[6], vr[6];
#pragma unroll
          for (int i = 0; i < 6; ++i) { const int p = tid + NTHREADS * i, rr = p >> 3, c8 = p & 7, s = i0 - 128 + rr;
              if (s >= 0) { const size_t off = ((size_t)b * SEQ + (size_t)s * dil + res) * D + h * 64 + c8 * 8; kr[i] = *(const v4u*)(KB + off); vr[i] = *(const v4u*)(VB + off); }
              else { kr[i] = (v4u){0u, 0u, 0u, 0u}; vr[i] = kr[i]; } }
#pragma unroll
          for (int i = 0; i < 6; ++i) { const int p = tid + NTHREADS * i, rr = p >> 3, c8 = p & 7;
              *(LAS v4u*)(lds + DA_K + rr * 144 + c8 * 16) = kr[i]; *(LAS v4u*)(lds + DA_V + rr * 144 + c8 * 16) = vr[i]; } }
        const int sq = i0 + 32 * w + r32; const size_t tq = (size_t)b * SEQ + (size_t)sq * dil + res;
        bf16* qp = QB + tq * 3072 + g * 1024 + h * 64;
        bf16x8 qf[4];
#pragma unroll
        for (int s = 0; s < 4; ++s) qf[s] = *(const bf16x8*)(qp + 16 * s + 8 * hi);
        LBAR();
        const int jt0 = (blk == 0) ? (w < 4 ? 4 - w : 0) : 0;
        f32x16 sc[5];
#pragma unroll
        for (int j = 0; j < 5; ++j) {
            if (j >= jt0) {
                f32x16 a;
#pragma unroll
                for (int r = 0; r < 16; ++r) a[r] = 0.f;
#pragma unroll
                for (int s = 0; s < 4; ++s) { const bf16x8 kf = *(const LAS bf16x8*)(lds + DA_K + (32 * w + 32 * j + r32) * 144 + (16 * s + 8 * hi) * 2);
                    a = __builtin_amdgcn_mfma_f32_32x32x16_bf16(kf, qf[s], a, 0, 0, 0); }
                if (j == 0) {
#pragma unroll
                    for (int r = 0; r < 16; ++r) if (crow(r, hi) < r32) a[r] = -INFINITY; }
                if (j == 4) {
#pragma unroll
                    for (int r = 0; r < 16; ++r) if (crow(r, hi) > r32) a[r] = -INFINITY; }
                sc[j] = a;
            } else {
#pragma unroll
                for (int r = 0; r < 16; ++r) sc[j][r] = -INFINITY;
            }
        }
        float mx = -INFINITY;
#pragma unroll
        for (int j = 0; j < 5; ++j)
#pragma unroll
            for (int r = 0; r < 16; ++r) mx = fmaxf(mx, sc[j][r]);
        mx = fmaxf(mx, __shfl_xor(mx, 32));
        float den = 0.f;
#pragma unroll
        for (int j = 0; j < 5; ++j)
#pragma unroll
            for (int r = 0; r < 16; ++r) { const float p = ex2(sc[j][r] - mx); sc[j][r] = p; den += p; }
        den += __shfl_xor(den, 32);
        f32x16 oT[2];
#pragma unroll
        for (int r = 0; r < 16; ++r) { oT[0][r] = 0.f; oT[1][r] = 0.f; }
        const int qq = (lane & 15) >> 2, pp = lane & 3, cg16 = (lane >> 4) & 1;
#pragma unroll
        for (int j = 0; j < 5; ++j) {
            if (j >= jt0) {
#pragma unroll
                for (int kk = 0; kk < 2; ++kk) {
                    v4u pw; pw.x = pk2(sc[j][8 * kk + 0], sc[j][8 * kk + 1]); pw.y = pk2(sc[j][8 * kk + 2], sc[j][8 * kk + 3]); pw.z = pk2(sc[j][8 * kk + 4], sc[j][8 * kk + 5]); pw.w = pk2(sc[j][8 * kk + 6], sc[j][8 * kk + 7]);
                    const bf16x8 pb = __builtin_bit_cast(bf16x8, pw);
#pragma unroll
                    for (int db = 0; db < 2; ++db) {
                        const LAS unsigned char* vp = lds + DA_V + (32 * w + 32 * j + 16 * kk + 4 * hi + qq) * 144 + (32 * db + 16 * cg16 + 4 * pp) * 2;
                        const s16x4 lo = vtr(vp), hi4 = vtr(vp + 8 * 144);
                        const bf16x8 va = (bf16x8){lo[0], lo[1], lo[2], lo[3], hi4[0], hi4[1], hi4[2], hi4[3]};
                        oT[db] = __builtin_amdgcn_mfma_f32_32x32x16_bf16(va, pb, oT[db], 0, 0, 0);
                    }
                }
            }
        }
        const float inv = 1.0f / den;
#pragma unroll
        for (int db = 0; db < 2; ++db)
#pragma unroll
            for (int rg = 0; rg < 4; ++rg)
                *(v2u*)(qp + 32 * db + 8 * rg + 4 * hi) = (v2u){pk2(oT[db][4 * rg] * inv, oT[db][4 * rg + 1] * inv), pk2(oT[db][4 * rg + 2] * inv, oT[db][4 * rg + 3] * inv)};
        if (hi == 0) ML[((size_t)g * M + tq) * 16 + h] = (f32x2){mx, den};
        LBAR();
    }
}
__device__ __forceinline__ void dil_merge_pass(Frame& F) {
    const int gw = F.vcu * NWAVES + F.wave; const int rpw = M / (F.G * NWAVES); const int r0 = gw * rpw;
    const bf16* QB = (const bf16*)(F.ws + WS_BIG); const f32x2* ML = (const f32x2*)(F.ws + WS_ML); bf16* HB = (bf16*)(F.ws + WS_H);
    const int c0 = 16 * F.lane, hd = F.lane >> 2;
    for (int r = r0; r < r0 + rpw; ++r) {
        f32x2 s[3]; float mm = -INFINITY;
#pragma unroll
        for (int g = 0; g < 3; ++g) { s[g] = ML[((size_t)g * M + r) * 16 + hd]; mm = fmaxf(mm, s[g].x); }
        float wg[3], ws = 0.f;
#pragma unroll
        for (int g = 0; g < 3; ++g) { wg[g] = s[g].y * ex2(s[g].x - mm); ws += wg[g]; }
        const float iw = 1.0f / ws;
        float acc[16];
#pragma unroll
        for (int e = 0; e < 16; ++e) acc[e] = 0.f;
#pragma unroll
        for (int g = 0; g < 3; ++g) { const float wv = wg[g] * iw;
#pragma unroll
            for (int hh = 0; hh < 2; ++hh) { const v4u ov = *(const v4u*)(QB + (size_t)r * 3072 + g * 1024 + c0 + 8 * hh);
                acc[8 * hh + 0] += wv * bflo(ov.x); acc[8 * hh + 1] += wv * bfhi(ov.x); acc[8 * hh + 2] += wv * bflo(ov.y); acc[8 * hh + 3] += wv * bfhi(ov.y);
                acc[8 * hh + 4] += wv * bflo(ov.z); acc[8 * hh + 5] += wv * bfhi(ov.z); acc[8 * hh + 6] += wv * bflo(ov.w); acc[8 * hh + 7] += wv * bfhi(ov.w); } }
#pragma unroll
        for (int hh = 0; hh < 2; ++hh)
            *(v4u*)(HB + (size_t)r * D + c0 + 8 * hh) = (v4u){pk2(acc[8 * hh], acc[8 * hh + 1]), pk2(acc[8 * hh + 2], acc[8 * hh + 3]), pk2(acc[8 * hh + 4], acc[8 * hh + 5]), pk2(acc[8 * hh + 6], acc[8 * hh + 7])};
    }
}

struct Args { const float* in[18]; float* out; unsigned char* ws; int ph_lo, ph_hi; };
constexpr int NPHASES = 2 + 8 * 2 + 9 + 8;
__global__ void __launch_bounds__(NTHREADS, 2) yoco_fwd(Args args) {
    extern __shared__ __attribute__((aligned(16))) unsigned char lds_raw[];
    Frame F;
    F.lds = (LAS unsigned char*)lds_raw;
    F.tid = threadIdx.x; F.lane = F.tid & 63; F.wave = __builtin_amdgcn_readfirstlane(F.tid >> 6);
    F.G = gridDim.x; F.bid = blockIdx.x; { const int bx = blockIdx.x; F.vcu = (F.G % 8 == 0) ? (bx % 8) * (F.G / 8) + bx / 8 : bx; }
    F.out = args.out; F.ws = args.ws;
    if (F.tid == 0) {
#pragma unroll
        for (int i = 0; i < 18; ++i) *(LAS unsigned long long*)(F.lds + PTAB_OFF + 8 * i) = (unsigned long long)args.in[i];
    }
    __syncthreads();
    cg::grid_group grid = cg::this_grid();
    const int lo = args.ph_lo, hi = args.ph_hi;
    int ph = 0;
#define RUN() (lo <= ph && ph < hi)
#define MODP ((const float*)(P.ws + WS_MOD))
#define KVMODP ((const float*)(P.ws + WS_KVMOD))
#define HBP ((bf16*)(P.ws + WS_H))
#define BIGP ((bf16*)(P.ws + WS_BIG))
#define BWP (((P.vcu * NWAVES + P.wave) * (M / (P.G * NWAVES))) / SEQ)
#define SEAM() do { if (lo <= ph && ph + 1 < hi) grid.sync(); ++ph; } while (0)

    if (RUN()) { Frame P = launder(F); p0_prologue(P); }
    SEAM();
    if (RUN()) { Frame P = launder(F); const float* m0 = MODP + (size_t)BWP * 6144; row_pass<false, false, 1>(P, inp(P, I_X), nullptr, nullptr, nullptr, m0 + 0, m0 + 1024, HBP, nullptr, nullptr, nullptr); }
    SEAM();
#pragma unroll 1
    for (int l = 0; l < DEPTH; ++l) {
        if (l < 2) {
            if (RUN()) { Frame P = launder(F); pg8::Gemm g{HBP, (const bf16*)(P.ws + WS_WGIN) + (size_t)l * GIN_NP * D, M, GIN_NP, D}; pg8::StaticOrder S; S.init(M, GIN_NP, P.G, P.bid);
                pg8::EpiGlaIn E{BIGP, (float*)(P.ws + WS_GLR), 0.08838834764831845f};
                pg8::gemm_phase<pg8::EpiGlaIn, pg8::StaticOrder, PG8_ALIGN, PG8_SP2>(P.lds, g, S, E, P.tid); }
            SEAM();
            if (RUN()) { Frame P = launder(F); gla_phase(P, l); }
            SEAM();
            if (RUN()) { Frame P = launder(F); gla_gate_pass(P, l); }
            SEAM();
        } else {
            if (l == 2) {
                if (RUN()) { Frame P = launder(F); pg8::Gemm g{BIGP, (const bf16*)(P.ws + WS_WKV), M, 2048, D}; pg8::StaticOrder S; S.init(M, 2048, P.G, P.bid);
                    pg8::EpiBf16<0> E{(bf16*)(P.ws + WS_O), D, nullptr, D, (size_t)(WS_V - WS_O) / 2, 1.0f};
                    pg8::gemm_phase<pg8::EpiBf16<0>, pg8::StaticOrder, PG8_ALIGN, PG8_SP2>(P.lds, g, S, E, P.tid); }
                SEAM();
            }
            if (RUN()) { Frame P = launder(F); pg8::Gemm g{HBP, (const bf16*)(P.ws + WS_WDQ) + (size_t)(l - 2) * 3072 * D, M, 3072, D}; pg8::StaticOrder S; S.init(M, 3072, P.G, P.bid);
                pg8::EpiBf16S E{BIGP, 3072, 0.125f * LOG2E};
                pg8::gemm_phase<pg8::EpiBf16S, pg8::StaticOrder, PG8_ALIGN, PG8_SP2>(P.lds, g, S, E, P.tid); }
            SEAM();
            if (RUN()) { Frame P = launder(F); dil_attn_phase(P); }
            SEAM();
            if (RUN()) { Frame P = launder(F); dil_merge_pass(P); }
            SEAM();
        }
        if (RUN()) { Frame P = launder(F); const bf16* wo = (l < 2) ? (const bf16*)(P.ws + WS_WGOUT) + (size_t)l * D * D : (const bf16*)(P.ws + WS_WDOUT) + (size_t)(l - 2) * D * D;
            pg8::Gemm g{HBP, wo, M, D, D}; pg8::StaticOrder S; S.init(M, D, P.G, P.bid);
            pg8::EpiResid E{l == 0 ? inp(P, I_X) : (const float*)P.out, P.out, (MODP + (size_t)l * NB * 6144) + 2048, ALPHA};
            pg8::gemm_phase<pg8::EpiResid, pg8::StaticOrder, PG8_ALIGN, PG8_SP2>(P.lds, g, S, E, P.tid); }
        SEAM();
        if (RUN()) { Frame P = launder(F); const float* mb = (MODP + (size_t)l * NB * 6144) + (size_t)BWP * 6144;
            row_pass<true, true, 1>(P, P.out, P.out, inp(P, I_LN_G) + (l * 2 + 0) * D, inp(P, I_LN_B) + (l * 2 + 0) * D, mb + 3072, mb + 4096, HBP, nullptr, nullptr, nullptr); }
        SEAM();
        if (RUN()) { Frame P = launder(F); pg8::Gemm g{HBP, (const bf16*)(P.ws + WS_WFIN) + (size_t)l * 2 * FF * D, M, 2 * FF, D}; pg8::StaticOrder S; S.init(M, 2 * FF, P.G, P.bid);
            pg8::EpiSwiglu E{BIGP, FF};
            pg8::gemm_phase<pg8::EpiSwiglu, pg8::StaticOrder, PG8_ALIGN, PG8_SP2>(P.lds, g, S, E, P.tid); }
        SEAM();
        if (RUN()) { Frame P = launder(F); pg8::Gemm g{BIGP, (const bf16*)(P.ws + WS_WFOUT) + (size_t)l * D * FF, M, D, FF}; pg8::StaticOrder S; S.init(M, D, P.G, P.bid);
            pg8::EpiResid E{P.out, P.out, (MODP + (size_t)l * NB * 6144) + 5120, ALPHA};
            pg8::gemm_phase<pg8::EpiResid, pg8::StaticOrder, PG8_ALIGN, PG8_SP2>(P.lds, g, S, E, P.tid); }
        SEAM();
        if (RUN()) { Frame P = launder(F); const float* lg = inp(P, I_LN_G) + (l * 2 + 1) * D; const float* lb = inp(P, I_LN_B) + (l * 2 + 1) * D;
            if (l == 3) row_pass<true, true, 0>(P, P.out, P.out, lg, lb, nullptr, nullptr, nullptr, nullptr, nullptr, nullptr);
            else { const float* mn = MODP + (size_t)(l + 1) * NB * 6144 + (size_t)BWP * 6144;
                if (l == 1) { const float* kvm = KVMODP + (size_t)BWP * 2048; row_pass<true, true, 2>(P, P.out, P.out, lg, lb, mn + 0, mn + 1024, HBP, kvm + 0, kvm + 1024, BIGP); }
                else row_pass<true, true, 1>(P, P.out, P.out, lg, lb, mn + 0, mn + 1024, HBP, nullptr, nullptr, nullptr); } }
        SEAM();
    }
#undef RUN
#undef SEAM
}

#ifndef DBG_STOP
#define DBG_STOP NPHASES
#endif
#ifndef DBG_SRC
#define DBG_SRC 0
#define DBG_LD 1024
#endif
__global__ void dbg_copy(const unsigned short* src, int ld, float* out) {
    const size_t i = (size_t)blockIdx.x * blockDim.x + threadIdx.x; const size_t r = i >> 10, c = i & 1023;
    out[i] = __uint_as_float((unsigned)src[r * ld + c] << 16);
}
extern "C" void kernel_launch(void* const* d_in, const int* in_sizes, int n_in, void* d_out, int out_size, void* d_ws, size_t ws_size, hipStream_t stream) {
    static int grid = 0;
    if (grid == 0) {
        if (n_in != 18 || in_sizes[0] != M * D || out_size != M * D || ws_size < WS_END) { fprintf(stderr, "kernel_launch: unexpected shapes/workspace (n_in %d, in0 %d, out %d, ws %zu, need %zu); nothing launched\n", n_in, n_in > 0 ? in_sizes[0] : -1, out_size, ws_size, (size_t)WS_END); grid = -1; return; }
        int dev = 0, cus = 0, per_cu = 0;
        if (hipGetDevice(&dev) != hipSuccess || hipDeviceGetAttribute(&cus, hipDeviceAttributeMultiprocessorCount, dev) != hipSuccess) { grid = -1; return; }
        if (hipFuncSetAttribute((const void*)yoco_fwd, hipFuncAttributeMaxDynamicSharedMemorySize, LDS_BYTES) != hipSuccess) { fprintf(stderr, "kernel_launch: hipFuncSetAttribute failed\n"); grid = -1; return; }
        if (hipOccupancyMaxActiveBlocksPerMultiprocessor(&per_cu, (const void*)yoco_fwd, NTHREADS, LDS_BYTES) != hipSuccess || per_cu < 1) { fprintf(stderr, "kernel_launch: occupancy query says %d\n", per_cu); per_cu = 1; }
        (void)hipGetLastError();
        grid = 256;
        if (cus * per_cu < grid) { fprintf(stderr, "kernel_launch: device holds %d x %d workgroups, need 256; nothing launched\n", cus, per_cu); grid = -1; return; }
    }
    if (grid < 0) return;
    Args a{};
    for (int i = 0; i < 18; ++i) a.in[i] = (const float*)d_in[i];
    a.out = (float*)d_out; a.ws = (unsigned char*)d_ws;
#if MK_PER_PHASE
    for (int p = 0; p < DBG_STOP; ++p) { a.ph_lo = p; a.ph_hi = p + 1; hipLaunchKernelGGL(yoco_fwd, dim3(grid), dim3(NTHREADS), LDS_BYTES, stream, a); }
    if (DBG_SRC) dbg_copy<<<M * D / 256, 256, 0, stream>>>((const unsigned short*)((unsigned char*)d_ws + (size_t)DBG_SRC * MiB), DBG_LD, (float*)d_out);
#else
    a.ph_lo = 0; a.ph_hi = NPHASES;
    void* kargs[] = {&a};
    hipError_t e = hipLaunchCooperativeKernel((const void*)yoco_fwd, dim3(grid), dim3(NTHREADS), kargs, LDS_BYTES, stream);
    if (e != hipSuccess) fprintf(stderr, "kernel_launch: cooperative launch failed: %s\n", hipGetErrorString(e));
#endif
}
```

```cpp
#include <hip/hip_runtime.h>
#include <cstdio>
#include <cstdint>
namespace pg8 {
#define PG8_LAS __attribute__((address_space(3)))
typedef unsigned short bf16_t;
typedef short bf16x8 __attribute__((ext_vector_type(8)));
typedef float f32x4 __attribute__((ext_vector_type(4)));
typedef unsigned u32x4 __attribute__((ext_vector_type(4)));
constexpr int BM = 256, BK = 64, HALF = 128, HTB = HALF * BK * 2  , STAGE_BYTES = 8 * HTB, NXCD = 8, WGM = 8;

__host__ __device__ __forceinline__ int lds_byte(int r, int c) { const int st = (r >> 4) * 2 + (c >> 5), rr = r & 15, cc = c & 31, ob = rr * 64 + cc * 2; return st * 1024 + (ob ^ (((ob >> 9) & 1) << 5)); }
__host__ __device__ __forceinline__ void stage_rc(int b, int& R, int& C) { const int st = b / 1024, sb = b % 1024, swz = sb ^ (((sb >> 9) & 1) << 5); R = (st >> 1) * 16 + swz / 64; C = (st & 1) * 32 + (swz % 64) / 2; }
__host__ __device__ __forceinline__ int perm32(int rho) { const int n = rho >> 4, i = rho & 15; return 8 * (i >> 2) + 4 * n + (i & 3); }

struct Unit { int pm, pn; };
struct Gemm { const bf16_t* A; const bf16_t* Bt; int M, N, K; };

struct StaticOrder {
    int nM, nN, nwg, G, c;
    __host__ __device__ void init(int M, int N, int G_, int c_) { nM = M / BM; nN = N / BM; nwg = nM * nN; G = G_; c = c_; }
    __host__ __device__ bool next(int i, Unit& u) const {
        const long L = (long)i * G + c; if (L >= nwg) return false;
        int wgid = (int)L; { const int q = nwg / NXCD, r = nwg % NXCD, xcd = wgid % NXCD, off = wgid / NXCD; wgid = (xcd < r ? xcd * (q + 1) : r * (q + 1) + (xcd - r) * q) + off; }
        const int nig = WGM * nN, gid = wgid / nig, fm = gid * WGM, gsz = (nM - fm) < WGM ? (nM - fm) : WGM;
        u.pm = fm + ((wgid % nig) % gsz); u.pn = (wgid % nig) / gsz; return true;
    }
    __device__ __forceinline__ void a_ready(const Unit&) const {}
    __device__ __forceinline__ void done(const Unit&) const {}
};

__device__ __forceinline__ unsigned cvt_pk_bf16(float lo, float hi) { unsigned r; asm volatile("v_cvt_pk_bf16_f32 %0, %1, %2" : "=v"(r) : "v"(lo), "v"(hi)); return r; }
typedef float f32x2 __attribute__((ext_vector_type(2)));
__device__ __forceinline__ f32x2 gelu_pk(f32x2 v) {
    const f32x2 av = __builtin_elementwise_abs(v), d = av * 0.2316418882f + 1.0f;
    f32x2 t; t.x = __builtin_amdgcn_rcpf(d.x); t.y = __builtin_amdgcn_rcpf(d.y);
    f32x2 q = t * 0.5307027145f + (-0.7265760135f); q = q * t + 0.7107068705f; q = q * t + (-0.142248368f); q = q * t + 0.127414796f; q = q * t;
    const f32x2 s = (v * v) * (-0.72134752044f);
    f32x2 e; e.x = __builtin_amdgcn_exp2f(s.x); e.y = __builtin_amdgcn_exp2f(s.y);
    const f32x2 m = v * (q * e), r = v - m;
    f32x2 o; o.x = v.x < 0.f ? m.x : r.x; o.y = v.y < 0.f ? m.y : r.y; return o;
}

template <int ACT  > struct EpiBf16 {
    static constexpr bool PERM = true, AFTER_DRAIN = false; static_assert(ACT == 0 || ACT == 1, "EpiBf16: ACT is 0 (none) or 1 (gelu_pk)");
    bf16_t* O; int ldc; const float* bias; int split_cols; size_t split_stride; float scale0;
    __device__ __forceinline__ void operator()(const f32x4 (&acc)[2][2][4][2], const Unit& u, int wr, int wc, int fr, int fq) const {
        const int row0 = u.pm * BM + wr * 64 + fr; int colt = u.pn * BM; bf16_t* base = O;
        float sc = 1.f; if (split_cols) { const int t = colt / split_cols; base += (size_t)t * split_stride; colt -= t * split_cols; if (t == 0) sc = scale0; }
        const int col0 = colt + wc * 32 + 8 * fq, bcol0 = u.pn * BM + wc * 32 + 8 * fq;
        f32x4 bv[2][2];
#pragma unroll
        for (int bj = 0; bj < 2; ++bj)
#pragma unroll
            for (int n = 0; n < 2; ++n) bv[bj][n] = bias ? *(const f32x4*)(bias + bcol0 + bj * HALF + 4 * n) : (f32x4){0.f, 0.f, 0.f, 0.f};
#pragma unroll
        for (int ai = 0; ai < 2; ++ai)
#pragma unroll
            for (int m = 0; m < 4; ++m) { bf16_t* rowp = base + (size_t)(row0 + ai * HALF + m * 16) * ldc + col0;
#pragma unroll
                for (int bj = 0; bj < 2; ++bj) { f32x4 v0 = acc[ai][bj][m][0] + bv[bj][0], v1 = acc[ai][bj][m][1] + bv[bj][1];
                    if (ACT == 1) { f32x2 a = gelu_pk((f32x2){v0[0], v0[1]}), b = gelu_pk((f32x2){v0[2], v0[3]}), c = gelu_pk((f32x2){v1[0], v1[1]}), d = gelu_pk((f32x2){v1[2], v1[3]});
                        v0 = (f32x4){a.x, a.y, b.x, b.y}; v1 = (f32x4){c.x, c.y, d.x, d.y}; }
                    v0 = v0 * sc; v1 = v1 * sc; u32x4 w; w.x = cvt_pk_bf16(v0[0], v0[1]); w.y = cvt_pk_bf16(v0[2], v0[3]); w.z = cvt_pk_bf16(v1[0], v1[1]); w.w = cvt_pk_bf16(v1[2], v1[3]);
                    *(u32x4*)(rowp + bj * HALF) = w; } }
    }
};

struct EpiBf16S {
    static constexpr bool PERM = true, AFTER_DRAIN = false;
    bf16_t* O; int ldc; float scale;
    __device__ __forceinline__ void operator()(const f32x4 (&acc)[2][2][4][2], const Unit& u, int wr, int wc, int fr, int fq) const {
        const int row0 = u.pm * BM + wr * 64 + fr, col0 = u.pn * BM + wc * 32 + 8 * fq;
#pragma unroll
        for (int ai = 0; ai < 2; ++ai)
#pragma unroll
            for (int m = 0; m < 4; ++m) { bf16_t* rowp = O + (size_t)(row0 + ai * HALF + m * 16) * ldc + col0;
#pragma unroll
                for (int bj = 0; bj < 2; ++bj) { const f32x4 v0 = acc[ai][bj][m][0] * scale, v1 = acc[ai][bj][m][1] * scale;
                    u32x4 w; w.x = cvt_pk_bf16(v0[0], v0[1]); w.y = cvt_pk_bf16(v0[2], v0[3]); w.z = cvt_pk_bf16(v1[0], v1[1]); w.w = cvt_pk_bf16(v1[2], v1[3]);
                    *(u32x4*)(rowp + bj * HALF) = w; } }
    }
};
struct EpiGlaIn {
    static constexpr bool PERM = true, AFTER_DRAIN = false;
    bf16_t* O; float* glr; float qscale;
    __device__ __forceinline__ void operator()(const f32x4 (&acc)[2][2][4][2], const Unit& u, int wr, int wc, int fr, int fq) const {
        const int row0 = u.pm * BM + wr * 64 + fr;
        if (u.pn < 12) {
            const float sc = (u.pn < 2) ? qscale : 1.f; const int col0 = u.pn * BM + wc * 32 + 8 * fq;
#pragma unroll
            for (int ai = 0; ai < 2; ++ai)
#pragma unroll
                for (int m = 0; m < 4; ++m) { bf16_t* rowp = O + (size_t)(row0 + ai * HALF + m * 16) * 3072 + col0;
#pragma unroll
                    for (int bj = 0; bj < 2; ++bj) { const f32x4 v0 = acc[ai][bj][m][0] * sc, v1 = acc[ai][bj][m][1] * sc;
                        u32x4 w; w.x = cvt_pk_bf16(v0[0], v0[1]); w.y = cvt_pk_bf16(v0[2], v0[3]); w.z = cvt_pk_bf16(v1[0], v1[1]); w.w = cvt_pk_bf16(v1[2], v1[3]);
                        *(u32x4*)(rowp + bj * HALF) = w; } }
        } else if (wc == 0 && fq < 2) {
#pragma unroll
            for (int ai = 0; ai < 2; ++ai)
#pragma unroll
                for (int m = 0; m < 4; ++m) { float* p = glr + (size_t)(row0 + ai * HALF + m * 16) * 16 + 8 * fq; *(f32x4*)p = acc[ai][0][m][0]; *(f32x4*)(p + 4) = acc[ai][0][m][1]; }
        }
    }
};
struct EpiResid {
    static constexpr bool PERM = true, AFTER_DRAIN = false;
    const float* xin; float* out; const float* gate; float alpha;
    __device__ __forceinline__ void operator()(const f32x4 (&acc)[2][2][4][2], const Unit& u, int wr, int wc, int fr, int fq) const {
        const int row0 = u.pm * BM + wr * 64 + fr, col0 = u.pn * BM + wc * 32 + 8 * fq;
        const float* gp = gate + (size_t)(u.pm >> 5) * 6144 + col0;
#pragma unroll
        for (int ai = 0; ai < 2; ++ai)
#pragma unroll
            for (int m = 0; m < 4; ++m) { const size_t off = (size_t)(row0 + ai * HALF + m * 16) * 1024 + col0;
#pragma unroll
                for (int bj = 0; bj < 2; ++bj)
#pragma unroll
                    for (int n = 0; n < 2; ++n) { const f32x4 xv = *(const f32x4*)(xin + off + bj * HALF + 4 * n); const f32x4 gv = *(const f32x4*)(gp + bj * HALF + 4 * n) + 1.0f;
                        *(f32x4*)(out + off + bj * HALF + 4 * n) = xv * alpha + gv * acc[ai][bj][m][n]; }
                asm volatile("" ::: "memory"); }
    }
};
struct EpiSwiglu {
    static constexpr bool PERM = true, AFTER_DRAIN = false;
    bf16_t* O; int ldc;
    __device__ __forceinline__ static float sw(float g, float uu) { return g * __builtin_amdgcn_rcpf(1.0f + __builtin_amdgcn_exp2f(-1.4426950408889634f * g)) * uu; }
    __device__ __forceinline__ void operator()(const f32x4 (&acc)[2][2][4][2], const Unit& u, int wr, int wc, int fr, int fq) const {
        const int row0 = u.pm * BM + wr * 64 + fr, col0 = u.pn * HALF + wc * 32 + 8 * fq;
#pragma unroll
        for (int ai = 0; ai < 2; ++ai)
#pragma unroll
            for (int m = 0; m < 4; ++m) { bf16_t* rowp = O + (size_t)(row0 + ai * HALF + m * 16) * ldc + col0;
                const f32x4 g0 = acc[ai][0][m][0], g1 = acc[ai][0][m][1], u0 = acc[ai][1][m][0], u1 = acc[ai][1][m][1];
                u32x4 w; w.x = cvt_pk_bf16(sw(g0[0], u0[0]), sw(g0[1], u0[1])); w.y = cvt_pk_bf16(sw(g0[2], u0[2]), sw(g0[3], u0[3]));
                w.z = cvt_pk_bf16(sw(g1[0], u1[0]), sw(g1[1], u1[1])); w.w = cvt_pk_bf16(sw(g1[2], u1[2]), sw(g1[3], u1[3]));
                *(u32x4*)rowp = w; }
    }
};

template <class Epi, class Sched, bool ALIGN_EPI = false, bool SP2 = false>
__device__ __forceinline__ void gemm_phase(PG8_LAS unsigned char* lds, const Gemm g, const Sched& S, const Epi& E, const int tid) {
    const int wid = __builtin_amdgcn_readfirstlane(tid >> 6), lane = tid & 63, wr = wid >> 2, wc = wid & 3, fr = lane & 15, fq = lane >> 4;
    const int K = g.K, nt = K / BK;
    unsigned voffA[2], voffB[2];
#pragma unroll
    for (int i = 0; i < 2; ++i) { int R, C; stage_rc(tid * 16 + i * 8192, R, C); const int Rb = Epi::PERM ? ((R & ~31) + perm32(R & 31)) : R;
        voffA[i] = (unsigned)(R * K + C) * 2u; voffB[i] = (unsigned)(Rb * K + C) * 2u; }
    const size_t kstep = (size_t)(BK * 2);
    const size_t hstep = (size_t)HALF * K * 2;
    const size_t tstep = 2 * hstep;
    const unsigned ldsw = (unsigned)wid * 1024u;
    const int aoff = lds_byte(wr * 64 + fr, fq * 8), boff = lds_byte(wc * 32 + fr, fq * 8);
#define PG8_SA(b, h) (((b) * 2 + (h)) * HTB)
#define PG8_SB(b, h) ((4 + (b) * 2 + (h)) * HTB)
#define PG8_STAGE(bufoff, gbase, voff) do { _Pragma("unroll") for (int _i = 0; _i < 2; ++_i) \
        __builtin_amdgcn_global_load_lds((const unsigned*)((const char*)(gbase) + (voff)[_i]), (PG8_LAS unsigned*)(lds + (bufoff) + ldsw + _i * 8192), 16, 0, 0); } while (0)
#define PG8_LDA(dst, b, h) do { _Pragma("unroll") for (int m = 0; m < 4; ++m) _Pragma("unroll") for (int k = 0; k < 2; ++k) dst[m][k] = *(const PG8_LAS bf16x8*)(lds + PG8_SA(b, h) + aoff + m * 2048 + k * 1024); } while (0)
#define PG8_LDB(dst, b, h) do { _Pragma("unroll") for (int n = 0; n < 2; ++n) _Pragma("unroll") for (int k = 0; k < 2; ++k) dst[n][k] = *(const PG8_LAS bf16x8*)(lds + PG8_SB(b, h) + boff + n * 2048 + k * 1024); } while (0)
#define PG8_MMA(ai, bj, At, Bt) do { __builtin_amdgcn_s_setprio(1); _Pragma("unroll") for (int m = 0; m < 4; ++m) _Pragma("unroll") for (int n = 0; n < 2; ++n) _Pragma("unroll") for (int k = 0; k < 2; ++k) \
        acc[ai][bj][m][n] = __builtin_amdgcn_mfma_f32_16x16x32_bf16(Bt[n][k], At[m][k], acc[ai][bj][m][n], 0, 0, 0); __builtin_amdgcn_s_setprio(0); } while (0)
#define PG8_WAIT_V(n) asm volatile("s_waitcnt vmcnt(" #n ")" ::: "memory")
#define PG8_WAIT_L(n) asm volatile("s_waitcnt lgkmcnt(" #n ")" ::: "memory")
#define PG8_BAR __builtin_amdgcn_s_barrier()
#define PG8_SCHED __builtin_amdgcn_sched_barrier(0)
    Unit cur, nxt; int ui = 0;
    if (!S.next(0, cur)) return;
    f32x4 acc[2][2][4][2];
#pragma unroll
    for (int a = 0; a < 2; ++a)
#pragma unroll
        for (int b = 0; b < 2; ++b)
#pragma unroll
            for (int m = 0; m < 4; ++m)
#pragma unroll
                for (int n = 0; n < 2; ++n) acc[a][b][m][n] = (f32x4){0.f, 0.f, 0.f, 0.f};
    bf16x8 At[4][2], B0[2][2], B1[2][2];
    const char* cA = (const char*)g.A + (size_t)cur.pm * tstep; const char* cB = (const char*)g.Bt + (size_t)cur.pn * tstep;
    S.a_ready(cur);
    if constexpr (SP2) {
        PG8_STAGE(PG8_SB(0, 0), cB, voffB); PG8_STAGE(PG8_SB(0, 1), cB + hstep, voffB); PG8_STAGE(PG8_SA(0, 0), cA, voffA); PG8_STAGE(PG8_SA(0, 1), cA + hstep, voffA);
        if (wr == 1) PG8_BAR;
        PG8_WAIT_V(2); PG8_BAR;
        PG8_STAGE(PG8_SB(1, 0), cB + kstep, voffB); PG8_STAGE(PG8_SA(1, 0), cA + kstep, voffA); PG8_STAGE(PG8_SB(1, 1), cB + hstep + kstep, voffB);
        PG8_WAIT_V(6); PG8_BAR;
    } else {
        PG8_STAGE(PG8_SB(0, 0), cB, voffB); PG8_STAGE(PG8_SA(0, 0), cA, voffA); PG8_STAGE(PG8_SB(0, 1), cB + hstep, voffB); PG8_STAGE(PG8_SA(0, 1), cA + hstep, voffA);
        if (wr == 1) PG8_BAR;
        PG8_WAIT_V(4); PG8_BAR;
        PG8_STAGE(PG8_SB(1, 0), cB + kstep, voffB); PG8_STAGE(PG8_SA(1, 0), cA + kstep, voffA); PG8_STAGE(PG8_SB(1, 1), cB + hstep + kstep, voffB);
        PG8_WAIT_V(6); PG8_BAR;
    }
    for (;;) {
        const bool has_next = S.next(ui + 1, nxt);
        const char* nA = has_next ? (const char*)g.A + (size_t)nxt.pm * tstep : cA; const char* nB = has_next ? (const char*)g.Bt + (size_t)nxt.pn * tstep : cB;
        for (int t = 0; t < nt; t += 2) {
            const bool last = (t == nt - 2);
            const char* a1 = cA + (size_t)(t + 1) * kstep;
            const char* a2 = last ? nA : cA + (size_t)(t + 2) * kstep; const char* b2 = last ? nB : cB + (size_t)(t + 2) * kstep;
            const char* a3 = a2 + kstep; const char* b3 = b2 + kstep;
            if (last && has_next) S.a_ready(nxt);
            if constexpr (SP2) {
            PG8_LDB(B0, 0, 0); PG8_LDB(B1, 0, 1); PG8_SCHED; PG8_LDA(At, 0, 0); PG8_STAGE(PG8_SA(1, 1), a1 + hstep, voffA);
            PG8_WAIT_V(8); PG8_WAIT_L(0); PG8_BAR; PG8_MMA(0, 0, At, B0); PG8_MMA(0, 1, At, B1); PG8_BAR; PG8_SCHED;
            PG8_LDA(At, 0, 1); PG8_STAGE(PG8_SB(0, 0), b2, voffB); PG8_STAGE(PG8_SB(0, 1), b2 + hstep, voffB); PG8_STAGE(PG8_SA(0, 0), a2, voffA);
            PG8_WAIT_V(8); PG8_WAIT_L(0); PG8_BAR; PG8_MMA(1, 0, At, B0); PG8_MMA(1, 1, At, B1); PG8_BAR; PG8_SCHED;
            PG8_LDB(B0, 1, 0); PG8_LDB(B1, 1, 1); PG8_SCHED; PG8_LDA(At, 1, 0); PG8_STAGE(PG8_SA(0, 1), a2 + hstep, voffA);
            PG8_WAIT_V(8); PG8_WAIT_L(0); PG8_BAR; PG8_MMA(0, 0, At, B0); PG8_MMA(0, 1, At, B1); PG8_BAR; PG8_SCHED;
            PG8_LDA(At, 1, 1); PG8_STAGE(PG8_SB(1, 0), b3, voffB); PG8_STAGE(PG8_SB(1, 1), b3 + hstep, voffB); PG8_STAGE(PG8_SA(1, 0), a3, voffA);
            PG8_WAIT_V(8); PG8_WAIT_L(0); PG8_BAR; PG8_MMA(1, 0, At, B0); PG8_MMA(1, 1, At, B1); PG8_BAR; PG8_SCHED;
            } else {
            PG8_LDB(B0, 0, 0); PG8_SCHED; PG8_LDA(At, 0, 0); PG8_STAGE(PG8_SA(1, 1), a1 + hstep, voffA);
            PG8_WAIT_L(8); PG8_BAR; PG8_WAIT_L(0); PG8_MMA(0, 0, At, B0); PG8_BAR; PG8_SCHED;
            PG8_LDB(B1, 0, 1); PG8_STAGE(PG8_SB(0, 0), b2, voffB);
            PG8_BAR; PG8_WAIT_L(0); PG8_MMA(0, 1, At, B1); PG8_BAR;
            PG8_LDA(At, 0, 1); PG8_STAGE(PG8_SA(0, 0), a2, voffA);
            PG8_BAR; PG8_WAIT_L(0); PG8_MMA(1, 0, At, B0); PG8_BAR; PG8_SCHED;
            PG8_STAGE(PG8_SB(0, 1), b2 + hstep, voffB);
            PG8_WAIT_V(6); PG8_BAR; PG8_MMA(1, 1, At, B1); PG8_BAR;
            PG8_LDB(B0, 1, 0); PG8_SCHED; PG8_LDA(At, 1, 0); PG8_STAGE(PG8_SA(0, 1), a2 + hstep, voffA);
            PG8_WAIT_L(8); PG8_BAR; PG8_WAIT_L(0); PG8_MMA(0, 0, At, B0); PG8_BAR; PG8_SCHED;
            PG8_LDB(B1, 1, 1); PG8_STAGE(PG8_SB(1, 0), b3, voffB);
            PG8_BAR; PG8_WAIT_L(0); PG8_MMA(0, 1, At, B1); PG8_BAR;
            PG8_LDA(At, 1, 1); PG8_STAGE(PG8_SA(1, 0), a3, voffA);
            PG8_BAR; PG8_WAIT_L(0); PG8_MMA(1, 0, At, B0); PG8_BAR; PG8_SCHED;
            PG8_STAGE(PG8_SB(1, 1), b3 + hstep, voffB);
            PG8_WAIT_V(6); PG8_BAR; PG8_MMA(1, 1, At, B1); PG8_BAR;
            }
        }
        if constexpr (ALIGN_EPI) { if (wr == 0) PG8_BAR; }
        if constexpr (!Epi::AFTER_DRAIN) { E(acc, cur, wr, wc, fr, fq); S.done(cur); }
        if (!has_next) break;
#pragma unroll
        for (int a = 0; a < 2; ++a)
#pragma unroll
            for (int b = 0; b < 2; ++b)
#pragma unroll
                for (int m = 0; m < 4; ++m)
#pragma unroll
                    for (int n = 0; n < 2; ++n) acc[a][b][m][n] = (f32x4){0.f, 0.f, 0.f, 0.f};
        cur = nxt; cA = nA; cB = nB; ++ui;
        if constexpr (ALIGN_EPI) { if (wr == 1) PG8_BAR; }
    }
    PG8_WAIT_V(0);
    if constexpr (!ALIGN_EPI) { if (wr == 0) PG8_BAR; }
    PG8_BAR;
    if constexpr (Epi::AFTER_DRAIN) { E.fused(acc, cur, wr, wc, fr, fq, lds, wid, lane); S.done(cur); }
#undef PG8_SA
#undef PG8_SB
#undef PG8_STAGE
#undef PG8_LDA
#undef PG8_LDB
#undef PG8_MMA
#undef PG8_WAIT_V
#undef PG8_WAIT_L
#undef PG8_BAR
#undef PG8_SCHED
}
}

#ifndef PG8_SP2
#define PG8_SP2 true
#endif
#ifndef PG8_ALIGN
#define PG8_ALIGN true
#endif
#include <hip/hip_cooperative_groups.h>
namespace cg = cooperative_groups;

#ifndef MK_PER_PHASE
#define MK_PER_PHASE 0
#endif
constexpr int NWAVES = 8, NTHREADS = 512;
constexpr int NB = 8, SEQ = 8192, D = 1024, M = NB * SEQ, DEPTH = 4;
constexpr int GIN_N = 3088, GIN_NP = 3328, FF = 2816;
constexpr float ALPHA = 1.6817928305074290f;
constexpr float LN_EPS = 1e-5f, RMS_EPS = 1e-5f;
constexpr float LOG2E = 1.4426950408889634f;

constexpr size_t MiB = 1u << 20;
constexpr size_t WS_MOD = 1 * MiB;
constexpr size_t WS_KVMOD = WS_MOD + (size_t)4 * 8 * 6144 * 4;
constexpr size_t WS_GLR = 2 * MiB;
constexpr size_t WS_WGIN = 6 * MiB;
constexpr size_t WS_WGOUT = 19 * MiB;
constexpr size_t WS_WDQ = 23 * MiB;
constexpr size_t WS_WDOUT = 35 * MiB;
constexpr size_t WS_WKV = 39 * MiB;
constexpr size_t WS_WFIN = 43 * MiB;
constexpr size_t WS_WFOUT = 87 * MiB;
constexpr size_t WS_ML = 110 * MiB;
constexpr size_t WS_H = 136 * MiB;
constexpr size_t WS_BIG = 264 * MiB;
constexpr size_t WS_O = 648 * MiB;
constexpr size_t WS_V = 776 * MiB;
constexpr size_t WS_END = 904 * MiB;

constexpr int RING_BYTES = 131072, LDS_BYTES = 147456;

#define GAS __attribute__((address_space(1)))
#define LAS __attribute__((address_space(3)))
typedef unsigned short bf16;
typedef unsigned v4u __attribute__((ext_vector_type(4)));
typedef unsigned v2u __attribute__((ext_vector_type(2)));
typedef float f32x4 __attribute__((ext_vector_type(4)));
typedef float f32x2 __attribute__((ext_vector_type(2)));
typedef float f32x16 __attribute__((ext_vector_type(16)));
typedef short bf16x8 __attribute__((ext_vector_type(8)));
typedef short s16x4 __attribute__((ext_vector_type(4)));
#define LDS_WAIT() asm volatile("s_waitcnt lgkmcnt(0)" ::: "memory")
#define LBAR() asm volatile("s_waitcnt lgkmcnt(0)\n\ts_barrier" ::: "memory")
typedef __bf16 bf16x2_t __attribute__((ext_vector_type(2)));
__device__ __forceinline__ unsigned pk2(float lo, float hi) { f32x2 v = {lo, hi}; bf16x2_t b = __builtin_convertvector(v, bf16x2_t); return __builtin_bit_cast(unsigned, b); }
__device__ __forceinline__ float bflo(unsigned u) { return __uint_as_float(u << 16); }
__device__ __forceinline__ float bfhi(unsigned u) { return __uint_as_float(u & 0xffff0000u); }
__device__ __forceinline__ float ex2(float x) { return __builtin_amdgcn_exp2f(x); }

struct Frame {
    LAS unsigned char* lds;
    int tid, lane, wave, vcu, G, bid;
    float* out; unsigned char* ws;
};
constexpr int PTAB_OFF = RING_BYTES + 1024;
enum { I_X = 0, I_C, I_GLA_W_IN, I_GLA_W_GATE_UP, I_GLA_B_GATE, I_GLA_NORM_G, I_GLA_W_OUT, I_DIL_W_Q, I_DIL_W_OUT, I_KV_ADA_W, I_KV_ADA_B, I_W_KV, I_FFN_W_IN, I_FFN_W_OUT, I_ADA_W, I_ADA_B, I_LN_G, I_LN_B };
__device__ __forceinline__ const float* inp(const Frame& F, int i) {
    const LAS unsigned* p = (const LAS unsigned*)(F.lds + PTAB_OFF + 8 * i);
    const unsigned lo = __builtin_amdgcn_readfirstlane(p[0]), hi = __builtin_amdgcn_readfirstlane(p[1]);
    return (const float*)(((unsigned long long)hi << 32) | lo);
}

__device__ __forceinline__ Frame launder(const Frame& F) {
    Frame P = F;
    asm volatile("" : "+v"(P.tid));
    P.lane = P.tid & 63; P.wave = __builtin_amdgcn_readfirstlane(P.tid >> 6);
    asm volatile("" : "+s"(P.vcu), "+s"(P.G), "+s"(P.bid));
    asm volatile("" : "+s"(P.out), "+s"(P.ws));
    asm volatile("" : "+s"(P.lds));
    return P;
}
__device__ __forceinline__ void p0_item(const float* W, int K, int N, bf16* WT, int mode, LAS float* scr, int item, int lane) {
    const int nblk = (N + 31) >> 5, kb = item / nblk, nb = item - kb * nblk, k0 = 64 * kb, n0 = 32 * nb;
    int d0 = n0;
    if (mode == 1) { const int s = nb / 88, wi = nb - s * 88, j0 = 32 * wi; d0 = 256 * (j0 >> 7) + 128 * s + (j0 & 127); }
    const bool okc = (n0 + (lane & 31)) < N;
#pragma unroll 8
    for (int i = 0; i < 32; ++i) { const int kk = 2 * i + (lane >> 5); scr[kk * 33 + (lane & 31)] = okc ? W[(size_t)(k0 + kk) * N + n0 + (lane & 31)] : 0.f; }
    LDS_WAIT(); asm volatile("" ::: "memory");
    const int c = lane & 7;
#pragma unroll
    for (int j = 0; j < 4; ++j) { const int n = (lane >> 3) + 8 * j; const LAS float* s = scr + (8 * c) * 33 + n;
        v4u o; o.x = pk2(s[0 * 33], s[1 * 33]); o.y = pk2(s[2 * 33], s[3 * 33]); o.z = pk2(s[4 * 33], s[5 * 33]); o.w = pk2(s[6 * 33], s[7 * 33]);
        *(v4u*)(WT + (size_t)(d0 + n) * K + k0 + 8 * c) = o; }
    LDS_WAIT(); asm volatile("" ::: "memory");
}
__device__ __forceinline__ void p0_prologue(Frame& F) {
    {
        LAS float* sc = (LAS float*)F.lds; LAS float* red = (LAS float*)(F.lds + 32768);
        const float* cin = inp(F, I_C);
        for (int i = F.tid; i < NB * D; i += NTHREADS) { const float v = cin[i]; sc[i] = v / (1.0f + __expf(-v)); }
        __syncthreads();
        for (int grp = F.bid; grp < 416; grp += F.G) {
            const float* W; const float* bias; float* outp; int N, n0;
            if (grp < 384) { const int l = grp / 96; n0 = (grp - l * 96) * 64; N = 6144; W = inp(F, I_ADA_W) + (size_t)l * D * 6144; bias = inp(F, I_ADA_B) + l * 6144; outp = (float*)(F.ws + WS_MOD) + (size_t)l * NB * 6144; }
            else { n0 = (grp - 384) * 64; N = 2048; W = inp(F, I_KV_ADA_W); bias = inp(F, I_KV_ADA_B); outp = (float*)(F.ws + WS_KVMOD); }
            float acc[NB];
#pragma unroll
            for (int b = 0; b < NB; ++b) acc[b] = 0.f;
            const float* wp = W + (size_t)(128 * F.wave) * N + n0 + F.lane;
#pragma unroll 8
            for (int kk = 0; kk < 128; ++kk) { const float wv = wp[(size_t)kk * N]; const int k = 128 * F.wave + kk;
#pragma unroll
                for (int b = 0; b < NB; ++b) acc[b] += sc[b * D + k] * wv; }
#pragma unroll
            for (int b = 0; b < NB; ++b) red[(F.wave * NB + b) * 64 + F.lane] = acc[b];
            __syncthreads();
            { const int b = F.wave; float s = bias[n0 + F.lane];
#pragma unroll
              for (int w2 = 0; w2 < NWAVES; ++w2) s += red[(w2 * NB + b) * 64 + F.lane];
              outp[(size_t)b * N + n0 + F.lane] = s; }
            __syncthreads();
        }
    }
    __syncthreads();
    LAS float* scr = (LAS float*)(F.lds + F.wave * 16384);
    const int gw = F.vcu * NWAVES + F.wave, NGW = F.G * NWAVES;
    constexpr int I_GIN = 16 * 97, I_SQ = 16 * 32, I_DQ = 16 * 96, I_KV = 16 * 64, I_FIN = 16 * 176, I_FOUT = 44 * 32;
    constexpr int NITEMS = 2 * I_GIN + 2 * I_SQ + 2 * I_DQ + 2 * I_SQ + I_KV + 4 * I_FIN + 4 * I_FOUT;
    for (int it = gw; it < NITEMS; it += NGW) {
        int r = it;
        if (r < 2 * I_GIN) { const int l = r / I_GIN; p0_item(inp(F, I_GLA_W_IN) + (size_t)l * D * GIN_N, D, GIN_N, (bf16*)(F.ws + WS_WGIN) + (size_t)l * GIN_NP * D, 0, scr, r - l * I_GIN, F.lane); continue; } r -= 2 * I_GIN;
        if (r < 2 * I_SQ) { const int l = r / I_SQ; p0_item(inp(F, I_GLA_W_OUT) + (size_t)l * D * D, D, D, (bf16*)(F.ws + WS_WGOUT) + (size_t)l * D * D, 0, scr, r - l * I_SQ, F.lane); continue; } r -= 2 * I_SQ;
        if (r < 2 * I_DQ) { const int l = r / I_DQ; p0_item(inp(F, I_DIL_W_Q) + (size_t)l * D * 3072, D, 3072, (bf16*)(F.ws + WS_WDQ) + (size_t)l * 3072 * D, 0, scr, r - l * I_DQ, F.lane); continue; } r -= 2 * I_DQ;
        if (r < 2 * I_SQ) { const int l = r / I_SQ; p0_item(inp(F, I_DIL_W_OUT) + (size_t)l * D * D, D, D, (bf16*)(F.ws + WS_WDOUT) + (size_t)l * D * D, 0, scr, r - l * I_SQ, F.lane); continue; } r -= 2 * I_SQ;
        if (r < I_KV) { p0_item(inp(F, I_W_KV), D, 2048, (bf16*)(F.ws + WS_WKV), 0, scr, r, F.lane); continue; } r -= I_KV;
        if (r < 4 * I_FIN) { const int l = r / I_FIN; p0_item(inp(F, I_FFN_W_IN) + (size_t)l * D * 2 * FF, D, 2 * FF, (bf16*)(F.ws + WS_WFIN) + (size_t)l * 2 * FF * D, 1, scr, r - l * I_FIN, F.lane); continue; } r -= 4 * I_FIN;
        { const int l = r / I_FOUT; p0_item(inp(F, I_FFN_W_OUT) + (size_t)l * FF * D, FF, D, (bf16*)(F.ws + WS_WFOUT) + (size_t)l * D * FF, 0, scr, r - l * I_FOUT, F.lane); }
    }
}

__device__ __forceinline__ float wave_sum(float v) {
#pragma unroll
    for (int o = 1; o < 64; o <<= 1) v += __shfl_xor(v, o);
    return v;
}
template <bool DO_LN, bool WRITE_X, int NOUT>
__device__ __forceinline__ void row_pass(Frame& F, const float* zin, float* xout, const float* lng, const float* lnb,
                                         const float* shA, const float* scA, bf16* hA, const float* shB, const float* scB, bf16* hB) {
    const int gw = F.vcu * NWAVES + F.wave; const int rpw = M / (F.G * NWAVES);
    const int r0 = gw * rpw; const int b = r0 / SEQ;
    const int cb = 4 * F.lane;
    f32x4 g[4], bb[4], s1A[4], shAv[4], s1B[4], shBv[4];
#pragma unroll
    for (int j = 0; j < 4; ++j) {
        if (DO_LN) { g[j] = *(const f32x4*)(lng + cb + 256 * j); bb[j] = *(const f32x4*)(lnb + cb + 256 * j); }
        if (NOUT >= 1) { s1A[j] = *(const f32x4*)(scA + cb + 256 * j) + 1.0f; shAv[j] = *(const f32x4*)(shA + cb + 256 * j); }
        if (NOUT >= 2) { s1B[j] = *(const f32x4*)(scB + cb + 256 * j) + 1.0f; shBv[j] = *(const f32x4*)(shB + cb + 256 * j); }
    }
    (void)b;
    for (int r = r0; r < r0 + rpw; ++r) {
        const float* zr = zin + (size_t)r * D + cb;
        f32x4 v[4];
#pragma unroll
        for (int j = 0; j < 4; ++j) v[j] = *(const f32x4*)(zr + 256 * j);
        if (DO_LN) {
            float s = 0.f;
#pragma unroll
            for (int j = 0; j < 4; ++j) s += (v[j].x + v[j].y) + (v[j].z + v[j].w);
            const float mean = wave_sum(s) * (1.f / D); float s2 = 0.f;
#pragma unroll
            for (int j = 0; j < 4; ++j) { v[j] = v[j] - mean; s2 += (v[j].x * v[j].x + v[j].y * v[j].y) + (v[j].z * v[j].z + v[j].w * v[j].w); }
            const float rstd = 1.f / sqrtf(wave_sum(s2) * (1.f / D) + LN_EPS);
#pragma unroll
            for (int j = 0; j < 4; ++j) v[j] = v[j] * rstd * g[j] + bb[j];
        }
        if (WRITE_X) {
            float* xr = xout + (size_t)r * D + cb;
#pragma unroll
            for (int j = 0; j < 4; ++j) *(f32x4*)(xr + 256 * j) = v[j];
        }
        if (NOUT >= 1) {
            bf16* hr = hA + (size_t)r * D + cb;
#pragma unroll
            for (int j = 0; j < 4; ++j) { const f32x4 o = v[j] * s1A[j] + shAv[j]; v2u w; w.x = pk2(o.x, o.y); w.y = pk2(o.z, o.w); *(v2u*)(hr + 256 * j) = w; }
        }
        if (NOUT >= 2) {
            bf16* hr = hB + (size_t)r * D + cb;
#pragma unroll
            for (int j = 0; j < 4; ++j) { const f32x4 o = v[j] * s1B[j] + shBv[j]; v2u w; w.x = pk2(o.x, o.y); w.y = pk2(o.z, o.w); *(v2u*)(hr + 256 * j) = w; }
        }
    }
}

constexpr size_t WS_QE = WS_V, WS_KDT = WS_V + 64 * MiB;
constexpr size_t WS_PG = WS_H, WS_DEC = WS_H + 32 * MiB;
constexpr int GP_GLR = 0, GP_TOT = 4096, GP_QE = 8192, GP_KE = GP_QE + 64 * 272, GP_END = GP_KE + 64 * 272;
__device__ __forceinline__ float logsig2(float z) {
    const float az = __builtin_fabsf(z);
    const float t = __builtin_amdgcn_exp2f(-az * LOG2E);
    const float l2 = __builtin_amdgcn_logf(1.0f + t);
    return (fminf(z, 0.f) * LOG2E - l2) * (1.0f / 16.0f);
}
__device__ __forceinline__ void gla_prepass(Frame& F, int l) {
    LAS unsigned char* lds = F.lds;
    const int tid = F.tid, lane = F.lane, w = F.wave, fr = lane & 15, quad = lane >> 4;
    const bf16* QKVR = (const bf16*)(F.ws + WS_BIG); const float* GLR = (const float*)(F.ws + WS_GLR);
    bf16* QEG = (bf16*)(F.ws + WS_QE); bf16* KDTG = (bf16*)(F.ws + WS_KDT); bf16* PG = (bf16*)(F.ws + WS_PG); float* DECG = (float*)(F.ws + WS_DEC);
    const int per = 4096 / F.G;
    int hcur = -1; float wg0[16], wg1[16]; f32x2 bgv = (f32x2){0.f, 0.f};
#pragma unroll
    for (int r = 0; r < 16; ++r) { wg0[r] = 0.f; wg1[r] = 0.f; }
    for (int ii = 0; ii < per; ++ii) {
        const int item = F.vcu * per + ii; const int bh = item >> 7, c = item & 127, b = bh >> 2, h = bh & 3;
        if (h != hcur) { hcur = h;
            const float* wgp = inp(F, I_GLA_W_GATE_UP) + (size_t)l * 16 * 512 + h * 128 + 2 * lane;
#pragma unroll
            for (int r = 0; r < 16; ++r) { const f32x2 t = *(const f32x2*)(wgp + r * 512); wg0[r] = t.x; wg1[r] = t.y; }
            bgv = *(const f32x2*)(inp(F, I_GLA_B_GATE) + l * 512 + h * 128 + 2 * lane); }
        const size_t row0 = (size_t)b * SEQ + (size_t)c * 64;
        const bf16* qsrc = QKVR + (row0 + 8 * w) * 3072 + h * 128 + 2 * lane;
        unsigned qc[8], kc[8];
#pragma unroll
        for (int i = 0; i < 8; ++i) { qc[i] = *(const unsigned*)(qsrc + (size_t)i * 3072); kc[i] = *(const unsigned*)(qsrc + (size_t)i * 3072 + 512); }
        const f32x2 gn = *(const f32x2*)(GLR + (row0 + (tid >> 3)) * 16 + 2 * (tid & 7));
        *(LAS f32x2*)(lds + GP_GLR + (tid >> 3) * 64 + (tid & 7) * 8) = gn;
        LBAR();
        float bl0[8], bl1[8];
        { float r0 = 0.f, r1 = 0.f;
#pragma unroll
          for (int i = 0; i < 8; ++i) {
            const LAS f32x4* gp = (const LAS f32x4*)(lds + GP_GLR + (8 * w + i) * 64);
            float z0 = bgv.x, z1 = bgv.y;
#pragma unroll
            for (int r4 = 0; r4 < 4; ++r4) { const f32x4 gvv = gp[r4];
                z0 += gvv.x * wg0[4 * r4] + gvv.y * wg0[4 * r4 + 1] + gvv.z * wg0[4 * r4 + 2] + gvv.w * wg0[4 * r4 + 3];
                z1 += gvv.x * wg1[4 * r4] + gvv.y * wg1[4 * r4 + 1] + gvv.z * wg1[4 * r4 + 2] + gvv.w * wg1[4 * r4 + 3]; }
            r0 += logsig2(z0); r1 += logsig2(z1); bl0[i] = r0; bl1[i] = r1; }
          *(LAS f32x2*)(lds + GP_TOT + (w * 128 + 2 * lane) * 4) = (f32x2){r0, r1}; }
        LBAR();
        { float off0 = 0.f, off1 = 0.f, all0 = 0.f, all1 = 0.f;
#pragma unroll
          for (int w2 = 0; w2 < 8; ++w2) { const f32x2 t = *(const LAS f32x2*)(lds + GP_TOT + (w2 * 128 + 2 * lane) * 4); all0 += t.x; all1 += t.y; if (w2 < w) { off0 += t.x; off1 += t.y; } }
          unsigned kd0[4], kd1[4];
          bf16* qeg = QEG + (size_t)item * 8192 + (8 * w) * 128 + 2 * lane;
#pragma unroll
          for (int i = 0; i < 8; ++i) {
            const float b0 = off0 + bl0[i], b1 = off1 + bl1[i];
            const float e0 = ex2(b0), e1 = ex2(b1), n0 = ex2(-b0), n1 = ex2(-b1), d0 = ex2(all0 - b0), d1 = ex2(all1 - b1);
            const float q0 = bflo(qc[i]), q1 = bfhi(qc[i]), k0 = bflo(kc[i]), k1 = bfhi(kc[i]);
            const unsigned qe = pk2(q0 * e0, q1 * e1);
            *(LAS unsigned*)(lds + GP_QE + (8 * w + i) * 272 + lane * 4) = qe;
            *(unsigned*)(qeg + i * 128) = qe;
            *(LAS unsigned*)(lds + GP_KE + (8 * w + i) * 272 + lane * 4) = pk2(k0 * n0, k1 * n1);
            const unsigned p = pk2(k0 * d0, k1 * d1);
            if (i & 1) { kd0[i >> 1] |= (p << 16); kd1[i >> 1] |= (p & 0xffff0000u); } else { kd0[i >> 1] = p & 0xffffu; kd1[i >> 1] = p >> 16; }
          }
          bf16* kdg = KDTG + (size_t)item * 8192 + (2 * lane) * 64 + 8 * w;
          *(v4u*)kdg = (v4u){kd0[0], kd0[1], kd0[2], kd0[3]};
          *(v4u*)(kdg + 64) = (v4u){kd1[0], kd1[1], kd1[2], kd1[3]};
          if (w == 0) *(f32x2*)(DECG + (size_t)item * 128 + 2 * lane) = (f32x2){ex2(all0), ex2(all1)}; }
        LBAR();
        { const int ib = w >> 1;
#pragma unroll
          for (int jj = 0; jj < 2; ++jj) { const int jb = 2 * (w & 1) + jj;
            f32x4 a = (f32x4){0.f, 0.f, 0.f, 0.f};
            if (jb <= ib) {
#pragma unroll
                for (int s = 0; s < 4; ++s) { const bf16x8 av = *(const LAS bf16x8*)(lds + GP_KE + (jb * 16 + fr) * 272 + (32 * s + 8 * quad) * 2);
                    const bf16x8 bv = *(const LAS bf16x8*)(lds + GP_QE + (ib * 16 + fr) * 272 + (32 * s + 8 * quad) * 2);
                    a = __builtin_amdgcn_mfma_f32_16x16x32_bf16(av, bv, a, 0, 0, 0); }
                const int ti = ib * 16 + fr, tj = jb * 16 + 4 * quad;
                if (tj + 0 > ti) a[0] = 0.f; if (tj + 1 > ti) a[1] = 0.f; if (tj + 2 > ti) a[2] = 0.f; if (tj + 3 > ti) a[3] = 0.f;
            }
            *(v2u*)(PG + (size_t)item * 4096 + (ib * 16 + fr) * 64 + jb * 16 + 4 * quad) = (v2u){pk2(a[0], a[1]), pk2(a[2], a[3])}; } }
    }
    LBAR();
}
constexpr int GS_QE = 0, GS_KDT = 64 * 272, GS_P = GS_KDT + 128 * 144, GS_VT = GS_P + 64 * 144, GS_DEC = GS_VT + 32 * 144, GS_BUF = GS_DEC + 512, GS_ST = 2 * GS_BUF, GS_END = GS_ST + 2 * 32 * 272;
static_assert(GS_END <= RING_BYTES && GP_END <= RING_BYTES, "GLA LDS map");
__device__ __forceinline__ void gla_phase(Frame& F, int l) {
    LAS unsigned char* lds = F.lds;
    const int tid = F.tid, lane = F.lane, w = F.wave, fr = lane & 15, quad = lane >> 4;
    const bf16* QKVR = (const bf16*)(F.ws + WS_BIG); bf16* OB = (bf16*)(F.ws + WS_O);
    const bf16* QEG = (const bf16*)(F.ws + WS_QE); const bf16* KDTG = (const bf16*)(F.ws + WS_KDT); const bf16* PG = (const bf16*)(F.ws + WS_PG); const float* DECG = (const float*)(F.ws + WS_DEC);
    (void)l;
    for (int unit = F.vcu; unit < 256; unit += F.G) {
        const int bh = unit >> 3, sl = unit & 7, b = bh >> 2, h = bh & 3;
        f32x4 st[2]; st[0] = (f32x4){0.f, 0.f, 0.f, 0.f}; st[1] = st[0];
        for (int i = tid; i < 32 * 272 / 4; i += NTHREADS) ((LAS unsigned*)(lds + GS_ST))[i] = 0u;
        const size_t rowb = (size_t)b * SEQ; const size_t item0 = (size_t)bh * 128;
        const bf16* qsrc = QEG + item0 * 8192 + (tid >> 3) * 128 + (tid & 7) * 16;
        const bf16* ksrc = KDTG + item0 * 8192 + (tid >> 2) * 64 + (tid & 3) * 16;
        const bf16* psrc = PG + item0 * 4096 + (tid >> 3) * 64 + (tid & 7) * 8;
        const float* dsrc = DECG + item0 * 128 + (tid & 127);
        const bf16* vsrc = QKVR + (rowb + (tid >> 3)) * 3072 + 1024 + h * 256 + sl * 32 + 4 * (tid & 7);
        const int oq = (tid >> 3) * 272 + (tid & 7) * 32, ok = (tid >> 2) * 144 + (tid & 3) * 32, op = (tid >> 3) * 144 + (tid & 7) * 16;
#define GS_LOAD(R, cc) do { const size_t c_ = (size_t)(cc); R##q0 = *(const v4u*)(qsrc + c_ * 8192); R##q1 = *(const v4u*)(qsrc + c_ * 8192 + 8); R##k0 = *(const v4u*)(ksrc + c_ * 8192); R##k1 = *(const v4u*)(ksrc + c_ * 8192 + 8); \
        R##p = *(const v4u*)(psrc + c_ * 4096); R##v = *(const v2u*)(vsrc + c_ * 64 * 3072); R##d = dsrc[c_ * 128]; } while (0)
#define GS_PUT(R, bufi) do { LAS unsigned char* B_ = lds + (bufi) * GS_BUF; *(LAS v4u*)(B_ + GS_QE + oq) = R##q0; *(LAS v4u*)(B_ + GS_QE + oq + 16) = R##q1; *(LAS v4u*)(B_ + GS_KDT + ok) = R##k0; *(LAS v4u*)(B_ + GS_KDT + ok + 16) = R##k1; \
        *(LAS v4u*)(B_ + GS_P + op) = R##p; if (tid < 128) *(LAS float*)(B_ + GS_DEC + tid * 4) = R##d; \
        { const int t_ = tid >> 3, w4_ = 4 * (tid & 7); LAS bf16* vt_ = (LAS bf16*)(B_ + GS_VT); vt_[(w4_ + 0) * 72 + t_] = (bf16)(R##v.x & 0xffffu); vt_[(w4_ + 1) * 72 + t_] = (bf16)(R##v.x >> 16); vt_[(w4_ + 2) * 72 + t_] = (bf16)(R##v.y & 0xffffu); vt_[(w4_ + 3) * 72 + t_] = (bf16)(R##v.y >> 16); } } while (0)
#define GS_COMPUTE(cc, bufi) do { const LAS unsigned char* B_ = lds + (bufi) * GS_BUF; const LAS unsigned char* S_ = lds + GS_ST + (bufi) * (32 * 272); LAS unsigned char* S2_ = lds + GS_ST + ((bufi) ^ 1) * (32 * 272); \
        const int wb = w & 1, ib = w >> 1; f32x4 o = (f32x4){0.f, 0.f, 0.f, 0.f}; \
        _Pragma("unroll") for (int s = 0; s < 2; ++s) { const bf16x8 av = *(const LAS bf16x8*)(B_ + GS_VT + (wb * 16 + fr) * 144 + (32 * s + 8 * quad) * 2); const bf16x8 bv = *(const LAS bf16x8*)(B_ + GS_P + (ib * 16 + fr) * 144 + (32 * s + 8 * quad) * 2); \
            o = __builtin_amdgcn_mfma_f32_16x16x32_bf16(av, bv, o, 0, 0, 0); } \
        _Pragma("unroll") for (int s = 0; s < 4; ++s) { const bf16x8 av = *(const LAS bf16x8*)(S_ + (wb * 16 + fr) * 272 + (32 * s + 8 * quad) * 2); const bf16x8 bv = *(const LAS bf16x8*)(B_ + GS_QE + (ib * 16 + fr) * 272 + (32 * s + 8 * quad) * 2); \
            o = __builtin_amdgcn_mfma_f32_16x16x32_bf16(av, bv, o, 0, 0, 0); } \
        *(v2u*)(OB + (rowb + (size_t)(cc) * 64 + ib * 16 + fr) * D + h * 256 + sl * 32 + wb * 16 + 4 * quad) = (v2u){pk2(o[0], o[1]), pk2(o[2], o[3])}; \
        const f32x4 dv = *(const LAS f32x4*)(B_ + GS_DEC + (16 * w + 4 * quad) * 4); \
        _Pragma("unroll") for (int cb2 = 0; cb2 < 2; ++cb2) { f32x4 a = st[cb2] * dv; \
            _Pragma("unroll") for (int s = 0; s < 2; ++s) { const bf16x8 av = *(const LAS bf16x8*)(B_ + GS_KDT + (16 * w + fr) * 144 + (32 * s + 8 * quad) * 2); const bf16x8 bv = *(const LAS bf16x8*)(B_ + GS_VT + (cb2 * 16 + fr) * 144 + (32 * s + 8 * quad) * 2); \
                a = __builtin_amdgcn_mfma_f32_16x16x32_bf16(av, bv, a, 0, 0, 0); } \
            st[cb2] = a; *(LAS v2u*)(S2_ + (cb2 * 16 + fr) * 272 + (16 * w + 4 * quad) * 2) = (v2u){pk2(a[0], a[1]), pk2(a[2], a[3])}; } } while (0)
        v4u Aq0, Aq1, Ak0, Ak1, Ap, Bq0, Bq1, Bk0, Bk1, Bp; v2u Av, Bv; float Ad, Bd;
        GS_LOAD(A, 0); GS_LOAD(B, 1);
        GS_PUT(A, 0);
        GS_LOAD(A, 2);
        LBAR();
        constexpr int NC = SEQ / 64;
        for (int c = 0; c < NC; c += 2) {
            GS_COMPUTE(c, 0);
            GS_PUT(B, 1);
            if (c + 3 < NC) GS_LOAD(B, c + 3);
            LBAR();
            GS_COMPUTE(c + 1, 1);
            if (c + 2 < NC) GS_PUT(A, 0);
            if (c + 4 < NC) GS_LOAD(A, c + 4);
            LBAR();
        }
#undef GS_LOAD
#undef GS_PUT
#undef GS_COMPUTE
    }
}

__device__ __forceinline__ void gla_gate_pass(Frame& F, int l) {
    const int gw = F.vcu * NWAVES + F.wave; const int rpw = M / (F.G * NWAVES); const int r0 = gw * rpw;
    const bf16* OB = (const bf16*)(F.ws + WS_O); const bf16* RB = (const bf16*)(F.ws + WS_BIG) + 2048; bf16* HB = (bf16*)(F.ws + WS_H);
    const int c0 = 8 * F.lane;
    const float* ng = inp(F, I_GLA_NORM_G) + l * 256 + (c0 & 255);
    const f32x4 ga = *(const f32x4*)ng, gb = *(const f32x4*)(ng + 4);
    for (int r = r0; r < r0 + rpw; ++r) {
#pragma unroll
        for (int hh = 0; hh < 2; ++hh) {
            const v4u ov = *(const v4u*)(OB + (size_t)r * D + 512 * hh + c0), rv = *(const v4u*)(RB + (size_t)r * 3072 + 512 * hh + c0);
            float o[8] = {bflo(ov.x), bfhi(ov.x), bflo(ov.y), bfhi(ov.y), bflo(ov.z), bfhi(ov.z), bflo(ov.w), bfhi(ov.w)};
            float rr[8] = {bflo(rv.x), bfhi(rv.x), bflo(rv.y), bfhi(rv.y), bflo(rv.z), bfhi(rv.z), bflo(rv.w), bfhi(rv.w)};
            float ss = 0.f;
#pragma unroll
            for (int e = 0; e < 8; ++e) ss += o[e] * o[e];
#pragma unroll
            for (int of = 1; of < 32; of <<= 1) ss += __shfl_xor(ss, of);
            const float rs = 1.0f / sqrtf(ss * (1.0f / 256.0f) + RMS_EPS);
            float a[8];
#pragma unroll
            for (int e = 0; e < 8; ++e) { const float gg = e < 4 ? ga[e] : gb[e - 4]; const float sl = rr[e] * __builtin_amdgcn_rcpf(1.0f + ex2(-LOG2E * rr[e])); a[e] = o[e] * rs * gg * sl; }
            *(v4u*)(HB + (size_t)r * D + 512 * hh + c0) = (v4u){pk2(a[0], a[1]), pk2(a[2], a[3]), pk2(a[4], a[5]), pk2(a[6], a[7])};
        }
    }
}

constexpr int DA_K = 0, DA_V = 384 * 144, DA_END = 2 * 384 * 144;
static_assert(DA_END <= RING_BYTES, "attention LDS map");
__device__ __forceinline__ int crow(int r, int hi) { return (r & 3) + 8 * (r >> 2) + 4 * hi; }
__device__ __forceinline__ s16x4 vtr(const LAS unsigned char* p) { return __builtin_bit_cast(s16x4, __builtin_amdgcn_ds_read_tr16_b64_v4i16((LAS s16x4*)p)); }
__device__ __forceinline__ void dil_attn_phase(Frame& F) {
    LAS unsigned char* lds = F.lds;
    const int tid = F.tid, lane = F.lane, w = F.wave, r32 = lane & 31, hi = lane >> 5;
    const bf16* KB = (const bf16*)(F.ws + WS_O); const bf16* VB = (const bf16*)(F.ws + WS_V); bf16* QB = (bf16*)(F.ws + WS_BIG); f32x2* ML = (f32x2*)(F.ws + WS_ML);
    const int per = 12288 / F.G;
    for (int ui = 0; ui < per; ++ui) {
        const int u = F.vcu * per + ui;
        const int bh = u / 96, rem = u - bh * 96, g = rem >> 5, idx = rem & 31;
        const int dil = 1 << (2 * g), lgn = 5 - 2 * g, res = idx >> lgn, blk = idx & ((1 << lgn) - 1);
        const int b = bh >> 4, h = bh & 15, i0 = blk * 256;
        { v4u kr[6], vr[6];
#pragma unroll
          for (int i = 0; i < 6; ++i) { const int p = tid + NTHREADS * i, rr = p >> 3, c8 = p & 7, s = i0 - 128 + rr;
              if (s >= 0) { const size_t off = ((size_t)b * SEQ + (size_t)s * dil + res) * D + h * 64 + c8 * 8; kr[i] = *(const v4u*)(KB + off); vr[i] = *(const v4u*)(VB + off); }
              else { kr[i] = (v4u){0u, 0u, 0u, 0u}; vr[i] = kr[i]; } }
#pragma unroll
          for (int i = 0; i < 6; ++i) { const int p = tid + NTHREADS * i, rr = p >> 3, c8 = p & 7;
              *(LAS v4u*)(lds + DA_K + rr * 144 + c8 * 16) = kr[i]; *(LAS v4u*)(lds + DA_V + rr * 144 + c8 * 16) = vr[i]; } }
        const int sq = i0 + 32 * w + r32; const size_t tq = (size_t)b * SEQ + (size_t)sq * dil + res;
        bf16* qp = QB + tq * 3072 + g * 1024 + h * 64;
        bf16x8 qf[4];
#pragma unroll
        for (int s = 0; s < 4; ++s) qf[s] = *(const bf16x8*)(qp + 16 * s + 8 * hi);
        LBAR();
        const int jt0 = (blk == 0) ? (w < 4 ? 4 - w : 0) : 0;
        f32x16 sc[5];
#pragma unroll
        for (int j = 0; j < 5; ++j) {
            if (j >= jt0) {
                f32x16 a;
#pragma unroll
                for (int r = 0; r < 16; ++r) a[r] = 0.f;
#pragma unroll
                for (int s = 0; s < 4; ++s) { const bf16x8 kf = *(const LAS bf16x8*)(lds + DA_K + (32 * w + 32 * j + r32) * 144 + (16 * s + 8 * hi) * 2);
                    a = __builtin_amdgcn_mfma_f32_32x32x16_bf16(kf, qf[s], a, 0, 0, 0); }
                if (j == 0) {
#pragma unroll
                    for (int r = 0; r < 16; ++r) if (crow(r, hi) < r32) a[r] = -INFINITY; }
                if (j == 4) {
#pragma unroll
                    for (int r = 0; r < 16; ++r) if (crow(r, hi) > r32) a[r] = -INFINITY; }
                sc[j] = a;
            } else {
#pragma unroll
                for (int r = 0; r < 16; ++r) sc[j][r] = -INFINITY;
            }
        }
        float mx = -INFINITY;
#pragma unroll
        for (int j = 0; j < 5; ++j)
#pragma unroll
            for (int r = 0; r < 16; ++r) mx = fmaxf(mx, sc[j][r]);
        mx = fmaxf(mx, __shfl_xor(mx, 32));
        float den = 0.f;
#pragma unroll
        for (int j = 0; j < 5; ++j)
#pragma unroll
            for (int r = 0; r < 16; ++r) { const float p = ex2(sc[j][r] - mx); sc[j][r] = p; den += p; }
        den += __shfl_xor(den, 32);
        f32x16 oT[2];
#pragma unroll
        for (int r = 0; r < 16; ++r) { oT[0][r] = 0.f; oT[1][r] = 0.f; }
        const int qq = (lane & 15) >> 2, pp = lane & 3, cg16 = (lane >> 4) & 1;
#pragma unroll
        for (int j = 0; j < 5; ++j) {
            if (j >= jt0) {
#pragma unroll
                for (int kk = 0; kk < 2; ++kk) {
                    v4u pw; pw.x = pk2(sc[j][8 * kk + 0], sc[j][8 * kk + 1]); pw.y = pk2(sc[j][8 * kk + 2], sc[j][8 * kk + 3]); pw.z = pk2(sc[j][8 * kk + 4], sc[j][8 * kk + 5]); pw.w = pk2(sc[j][8 * kk + 6], sc[j][8 * kk + 7]);
                    const bf16x8 pb = __builtin_bit_cast(bf16x8, pw);
#pragma unroll
                    for (int db = 0; db < 2; ++db) {
                        const LAS unsigned char* vp = lds + DA_V + (32 * w + 32 * j + 16 * kk + 4 * hi + qq) * 144 + (32 * db + 16 * cg16 + 4 * pp) * 2;
                        const s16x4 lo = vtr(vp), hi4 = vtr(vp + 8 * 144);
                        const bf16x8 va = (bf16x8){lo[0], lo[1], lo[2], lo[3], hi4[0], hi4[1], hi4[2], hi4[3]};
                        oT[db] = __builtin_amdgcn_mfma_f32_32x32x16_bf16(va, pb, oT[db], 0, 0, 0);
                    }
                }
            }
        }
        const float inv = 1.0f / den;
#pragma unroll
        for (int db = 0; db < 2; ++db)
#pragma unroll
            for (int rg = 0; rg < 4; ++rg)
                *(v2u*)(qp + 32 * db + 8 * rg + 4 * hi) = (v2u){pk2(oT[db][4 * rg] * inv, oT[db][4 * rg + 1] * inv), pk2(oT[db][4 * rg + 2] * inv, oT[db][4 * rg + 3] * inv)};
        if (hi == 0) ML[((size_t)g * M + tq) * 16 + h] = (f32x2){mx, den};
        LBAR();
    }
}
__device__ __forceinline__ void dil_merge_pass(Frame& F) {
    const int gw = F.vcu * NWAVES + F.wave; const int rpw = M / (F.G * NWAVES); const int r0 = gw * rpw;
    const bf16* QB = (const bf16*)(F.ws + WS_BIG); const f32x2* ML = (const f32x2*)(F.ws + WS_ML); bf16* HB = (bf16*)(F.ws + WS_H);
    const int c0 = 16 * F.lane, hd = F.lane >> 2;
    for (int r = r0; r < r0 + rpw; ++r) {
        f32x2 s[3]; float mm = -INFINITY;
#pragma unroll
        for (int g = 0; g < 3; ++g) { s[g] = ML[((size_t)g * M + r) * 16 + hd]; mm = fmaxf(mm, s[g].x); }
        float wg[3], ws = 0.f;
#pragma unroll
        for (int g = 0; g < 3; ++g) { wg[g] = s[g].y * ex2(s[g].x - mm); ws += wg[g]; }
        const float iw = 1.0f / ws;
        float acc[16];
#pragma unroll
        for (int e = 0; e < 16; ++e) acc[e] = 0.f;
#pragma unroll
        for (int g = 0; g < 3; ++g) { const float wv = wg[g] * iw;
#pragma unroll
            for (int hh = 0; hh < 2; ++hh) { const v4u ov = *(const v4u*)(QB + (size_t)r * 3072 + g * 1024 + c0 + 8 * hh);
                acc[8 * hh + 0] += wv * bflo(ov.x); acc[8 * hh + 1] += wv * bfhi(ov.x); acc[8 * hh + 2] += wv * bflo(ov.y); acc[8 * hh + 3] += wv * bfhi(ov.y);
                acc[8 * hh + 4] += wv * bflo(ov.z); acc[8 * hh + 5] += wv * bfhi(ov.z); acc[8 * hh + 6] += wv * bflo(ov.w); acc[8 * hh + 7] += wv * bfhi(ov.w); } }
#pragma unroll
        for (int hh = 0; hh < 2; ++hh)
            *(v4u*)(HB + (size_t)r * D + c0 + 8 * hh) = (v4u){pk2(acc[8 * hh], acc[8 * hh + 1]), pk2(acc[8 * hh + 2], acc[8 * hh + 3]), pk2(acc[8 * hh + 4], acc[8 * hh + 5]), pk2(acc[8 * hh + 6], acc[8 * hh + 7])};
    }
}

struct Args { const float* in[18]; float* out; unsigned char* ws; int ph_lo, ph_hi; };
constexpr int NPHASES = 2 + 9 * 2 + 9 + 8;
__global__ void __launch_bounds__(NTHREADS, 2) yoco_fwd(Args args) {
    extern __shared__ __attribute__((aligned(16))) unsigned char lds_raw[];
    Frame F;
    F.lds = (LAS unsigned char*)lds_raw;
    F.tid = threadIdx.x; F.lane = F.tid & 63; F.wave = __builtin_amdgcn_readfirstlane(F.tid >> 6);
    F.G = gridDim.x; F.bid = blockIdx.x; { const int bx = blockIdx.x; F.vcu = (F.G % 8 == 0) ? (bx % 8) * (F.G / 8) + bx / 8 : bx; }
    F.out = args.out; F.ws = args.ws;
    if (F.tid == 0) {
#pragma unroll
        for (int i = 0; i < 18; ++i) *(LAS unsigned long long*)(F.lds + PTAB_OFF + 8 * i) = (unsigned long long)args.in[i];
    }
    __syncthreads();
    cg::grid_group grid = cg::this_grid();
    const int lo = args.ph_lo, hi = args.ph_hi;
    int ph = 0;
#define RUN() (lo <= ph && ph < hi)
#define MODP ((const float*)(P.ws + WS_MOD))
#define KVMODP ((const float*)(P.ws + WS_KVMOD))
#define HBP ((bf16*)(P.ws + WS_H))
#define BIGP ((bf16*)(P.ws + WS_BIG))
#define BWP (((P.vcu * NWAVES + P.wave) * (M / (P.G * NWAVES))) / SEQ)
#define SEAM() do { if (lo <= ph && ph + 1 < hi) grid.sync(); ++ph; } while (0)

    if (RUN()) { Frame P = launder(F); p0_prologue(P); }
    SEAM();
    if (RUN()) { Frame P = launder(F); const float* m0 = MODP + (size_t)BWP * 6144; row_pass<false, false, 1>(P, inp(P, I_X), nullptr, nullptr, nullptr, m0 + 0, m0 + 1024, HBP, nullptr, nullptr, nullptr); }
    SEAM();
#pragma unroll 1
    for (int l = 0; l < DEPTH; ++l) {
        if (l < 2) {
            if (RUN()) { Frame P = launder(F); pg8::Gemm g{HBP, (const bf16*)(P.ws + WS_WGIN) + (size_t)l * GIN_NP * D, M, GIN_NP, D}; pg8::StaticOrder S; S.init(M, GIN_NP, P.G, P.bid);
                pg8::EpiGlaIn E{BIGP, (float*)(P.ws + WS_GLR), 0.08838834764831845f};
                pg8::gemm_phase<pg8::EpiGlaIn, pg8::StaticOrder, PG8_ALIGN, PG8_SP2>(P.lds, g, S, E, P.tid); }
            SEAM();
            if (RUN()) { Frame P = launder(F); gla_prepass(P, l); }
            SEAM();
            if (RUN()) { Frame P = launder(F); gla_phase(P, l); }
            SEAM();
            if (RUN()) { Frame P = launder(F); gla_gate_pass(P, l); }
            SEAM();
        } else {
            if (l == 2) {
                if (RUN()) { Frame P = launder(F); pg8::Gemm g{BIGP, (const bf16*)(P.ws + WS_WKV), M, 2048, D}; pg8::StaticOrder S; S.init(M, 2048, P.G, P.bid);
                    pg8::EpiBf16<0> E{(bf16*)(P.ws + WS_O), D, nullptr, D, (size_t)(WS_V - WS_O) / 2, 1.0f};
                    pg8::gemm_phase<pg8::EpiBf16<0>, pg8::StaticOrder, PG8_ALIGN, PG8_SP2>(P.lds, g, S, E, P.tid); }
                SEAM();
            }
            if (RUN()) { Frame P = launder(F); pg8::Gemm g{HBP, (const bf16*)(P.ws + WS_WDQ) + (size_t)(l - 2) * 3072 * D, M, 3072, D}; pg8::StaticOrder S; S.init(M, 3072, P.G, P.bid);
                pg8::EpiBf16S E{BIGP, 3072, 0.125f * LOG2E};
                pg8::gemm_phase<pg8::EpiBf16S, pg8::StaticOrder, PG8_ALIGN, PG8_SP2>(P.lds, g, S, E, P.tid); }
            SEAM();
            if (RUN()) { Frame P = launder(F); dil_attn_phase(P); }
            SEAM();
            if (RUN()) { Frame P = launder(F); dil_merge_pass(P); }
            SEAM();
        }
        if (RUN()) { Frame P = launder(F); const bf16* wo = (l < 2) ? (const bf16*)(P.ws + WS_WGOUT) + (size_t)l * D * D : (const bf16*)(P.ws + WS_WDOUT) + (size_t)(l - 2) * D * D;
            pg8::Gemm g{HBP, wo, M, D, D}; pg8::StaticOrder S; S.init(M, D, P.G, P.bid);
            pg8::EpiResid E{l == 0 ? inp(P, I_X) : (const float*)P.out, P.out, (MODP + (size_t)l * NB * 6144) + 2048, ALPHA};
            pg8::gemm_phase<pg8::EpiResid, pg8::StaticOrder, PG8_ALIGN, PG8_SP2>(P.lds, g, S, E, P.tid); }
        SEAM();
        if (RUN()) { Frame P = launder(F); const float* mb = (MODP + (size_t)l * NB * 6144) + (size_t)BWP * 6144;
            row_pass<true, true, 1>(P, P.out, P.out, inp(P, I_LN_G) + (l * 2 + 0) * D, inp(P, I_LN_B) + (l * 2 + 0) * D, mb + 3072, mb + 4096, HBP, nullptr, nullptr, nullptr); }
        SEAM();
        if (RUN()) { Frame P = launder(F); pg8::Gemm g{HBP, (const bf16*)(P.ws + WS_WFIN) + (size_t)l * 2 * FF * D, M, 2 * FF, D}; pg8::StaticOrder S; S.init(M, 2 * FF, P.G, P.bid);
            pg8::EpiSwiglu E{BIGP, FF};
            pg8::gemm_phase<pg8::EpiSwiglu, pg8::StaticOrder, PG8_ALIGN, PG8_SP2>(P.lds, g, S, E, P.tid); }
        SEAM();
        if (RUN()) { Frame P = launder(F); pg8::Gemm g{BIGP, (const bf16*)(P.ws + WS_WFOUT) + (size_t)l * D * FF, M, D, FF}; pg8::StaticOrder S; S.init(M, D, P.G, P.bid);
            pg8::EpiResid E{P.out, P.out, (MODP + (size_t)l * NB * 6144) + 5120, ALPHA};
            pg8::gemm_phase<pg8::EpiResid, pg8::StaticOrder, PG8_ALIGN, PG8_SP2>(P.lds, g, S, E, P.tid); }
        SEAM();
        if (RUN()) { Frame P = launder(F); const float* lg = inp(P, I_LN_G) + (l * 2 + 1) * D; const float* lb = inp(P, I_LN_B) + (l * 2 + 1) * D;
            if (l == 3) row_pass<true, true, 0>(P, P.out, P.out, lg, lb, nullptr, nullptr, nullptr, nullptr, nullptr, nullptr);
            else { const float* mn = MODP + (size_t)(l + 1) * NB * 6144 + (size_t)BWP * 6144;
                if (l == 1) { const float* kvm = KVMODP + (size_t)BWP * 2048; row_pass<true, true, 2>(P, P.out, P.out, lg, lb, mn + 0, mn + 1024, HBP, kvm + 0, kvm + 1024, BIGP); }
                else row_pass<true, true, 1>(P, P.out, P.out, lg, lb, mn + 0, mn + 1024, HBP, nullptr, nullptr, nullptr); } }
        SEAM();
    }
#undef RUN
#undef SEAM
}

extern "C" void kernel_launch(void* const* d_in, const int* in_sizes, int n_in, void* d_out, int out_size, void* d_ws, size_t ws_size, hipStream_t stream) {
    static int grid = 0;
    if (grid == 0) {
        if (n_in != 18 || in_sizes[0] != M * D || out_size != M * D || ws_size < WS_END) { fprintf(stderr, "kernel_launch: unexpected shapes/workspace (n_in %d, in0 %d, out %d, ws %zu, need %zu); nothing launched\n", n_in, n_in > 0 ? in_sizes[0] : -1, out_size, ws_size, (size_t)WS_END); grid = -1; return; }
        int dev = 0, cus = 0, per_cu = 0;
        if (hipGetDevice(&dev) != hipSuccess || hipDeviceGetAttribute(&cus, hipDeviceAttributeMultiprocessorCount, dev) != hipSuccess) { grid = -1; return; }
        if (hipFuncSetAttribute((const void*)yoco_fwd, hipFuncAttributeMaxDynamicSharedMemorySize, LDS_BYTES) != hipSuccess) { fprintf(stderr, "kernel_launch: hipFuncSetAttribute failed\n"); grid = -1; return; }
        if (hipOccupancyMaxActiveBlocksPerMultiprocessor(&per_cu, (const void*)yoco_fwd, NTHREADS, LDS_BYTES) != hipSuccess || per_cu < 1) { fprintf(stderr, "kernel_launch: occupancy query says %d\n", per_cu); per_cu = 1; }
        (void)hipGetLastError();
        grid = 256;
        if (cus * per_cu < grid) { fprintf(stderr, "kernel_launch: device holds %d x %d workgroups, need 256; nothing launched\n", cus, per_cu); grid = -1; return; }
    }
    if (grid < 0) return;
    Args a{};
    for (int i = 0; i < 18; ++i) a.in[i] = (const float*)d_in[i];
    a.out = (float*)d_out; a.ws = (unsigned char*)d_ws;
#if MK_PER_PHASE
    for (int p = 0; p < NPHASES; ++p) { a.ph_lo = p; a.ph_hi = p + 1; hipLaunchKernelGGL(yoco_fwd, dim3(grid), dim3(NTHREADS), LDS_BYTES, stream, a); }
#else
    a.ph_lo = 0; a.ph_hi = NPHASES;
    void* kargs[] = {&a};
    hipError_t e = hipLaunchCooperativeKernel((const void*)yoco_fwd, dim3(grid), dim3(NTHREADS), kargs, LDS_BYTES, stream);
    if (e != hipSuccess) fprintf(stderr, "kernel_launch: cooperative launch failed: %s\n", hipGetErrorString(e));
#endif
}
```
